# Optimizing an MI355X kernel written in HIP

```python
import math
import jax
import jax.numpy as jnp
from jax import lax
import numpy as np

D_MODEL = 1024
BATCH = 2
SEQ = 16384
DEPTH = 1

HEAD_DIM = 64
HEADS_PER_GROUP = 4
ATTN_GROUPS = ((128, 1), (512, 4), (2048, 16))
N_ATTN_HEADS = HEADS_PER_GROUP * len(ATTN_GROUPS)
ATTN_WIDTH = N_ATTN_HEADS * HEAD_DIM
ATTN_OUT_WIDTH = HEADS_PER_GROUP * HEAD_DIM
ROPE_THETA = 10000.0
SSM_WIDTH = D_MODEL // 2
SSM_GROUP = 16
SSM_GROUPS = SSM_WIDTH // SSM_GROUP
SSM_STATE = 64
DT_MIN = 0.001
DT_MAX = 0.1
N_BRANCHES = 2
IN_WIDTH = 3 * ATTN_WIDTH + SSM_WIDTH + N_BRANCHES * D_MODEL
N_EXPERTS = 32
TOP_K = 4
D_EXPERT = D_MODEL
SWIGLU_ALPHA = 1.702
SWIGLU_LIMIT = 7.0
MOE_BLOCK = 256
NORM_EPS = 1e-6
MASK_VALUE = -1e30

kernel_name = 'hybrid_dilated_attn_s5_moe_block'


def _rmsnorm(x, gain):
    x32 = x.astype(jnp.float32)
    y = x32 * lax.rsqrt(jnp.mean(x32 * x32, axis=-1, keepdims=True) + NORM_EPS)
    return (y * gain.astype(jnp.float32)).astype(x.dtype)


def _rope(t):
    seq, dh = t.shape[1], t.shape[-1]
    inv_freq = ROPE_THETA ** (-jnp.arange(0, dh, 2, dtype=jnp.float32) / dh)
    ang = jnp.arange(seq, dtype=jnp.float32)[:, None] * inv_freq[None, :]
    cos = jnp.cos(ang)[None, :, None, :]
    sin = jnp.sin(ang)[None, :, None, :]
    t32 = t.astype(jnp.float32)
    t1, t2 = t32[..., : dh // 2], t32[..., dh // 2:]
    return jnp.concatenate([t1 * cos - t2 * sin, t2 * cos + t1 * sin], axis=-1).astype(t.dtype)


def _banded_attention(q, k, v, half):
    n, length, heads, dh = q.shape
    nb = -(-length // half)
    pad = nb * half - length
    qb = jnp.pad(q, ((0, 0), (0, pad), (0, 0), (0, 0))).reshape(n, nb, half, heads, dh)

    def windows(t):
        tp = jnp.pad(t, ((0, 0), (half, pad + half), (0, 0), (0, 0))).reshape(n, nb + 2, half, heads, dh)
        return jnp.concatenate([tp[:, :-2], tp[:, 1:-1], tp[:, 2:]], axis=2)

    kw = windows(k)
    vw = windows(v)
    scores = jnp.einsum('nbqhd,nbkhd->nbhqk', qb, kw).astype(jnp.float32) * (dh ** -0.5)
    blk = jnp.arange(nb)[:, None]
    qpos = blk * half + jnp.arange(half)[None, :]
    kpos = (blk - 1) * half + jnp.arange(3 * half)[None, :]
    rel = kpos[:, None, :] - qpos[:, :, None]
    valid = (jnp.abs(rel) <= half) & (kpos[:, None, :] >= 0) & (kpos[:, None, :] < length)
    scores = jnp.where(valid[None, :, None], scores, MASK_VALUE)
    m = jnp.max(scores, axis=-1, keepdims=True)
    p = jnp.exp(scores - m)
    denom = jnp.sum(p, axis=-1)
    o = jnp.einsum('nbhqk,nbkhd->nbqhd', p, vw.astype(jnp.float32)) / jnp.swapaxes(denom, 2, 3)[..., None]
    lse = jnp.swapaxes(m[..., 0] + jnp.log(denom), 2, 3)
    o = o.reshape(n, nb * half, heads, dh)[:, :length]
    lse = lse.reshape(n, nb * half, heads)[:, :length]
    return o, lse


def _dilated_group(q, k, v, window, dilation):
    bsz, seq, heads, dh = q.shape
    length = seq // dilation
    half = window // (2 * dilation)

    def split(t):
        return t.reshape(bsz, length, dilation, heads, dh).transpose(0, 2, 1, 3, 4).reshape(bsz * dilation, length, heads, dh)

    o, lse = _banded_attention(split(q), split(k), split(v), half)
    o = o.reshape(bsz, dilation, length, heads, dh).transpose(0, 2, 1, 3, 4).reshape(bsz, seq, heads, dh)
    lse = lse.reshape(bsz, dilation, length, heads).transpose(0, 2, 1, 3).reshape(bsz, seq, heads)
    return o, lse


def _dilated_attention_mixer(q, k, v):
    bsz, seq = q.shape[0], q.shape[1]
    outs = []
    lses = []
    for g, (window, dilation) in enumerate(ATTN_GROUPS):
        sl = slice(g * HEADS_PER_GROUP, (g + 1) * HEADS_PER_GROUP)
        o, lse = _dilated_group(q[:, :, sl], k[:, :, sl], v[:, :, sl], window, dilation)
        outs.append(o)
        lses.append(lse)
    o = jnp.stack(outs)
    weights = jax.nn.softmax(jnp.stack(lses), axis=0)
    y = jnp.sum(weights[..., None] * o, axis=0)
    return y.reshape(bsz, seq, ATTN_OUT_WIDTH).astype(q.dtype)


def _complex_linear_combine(e1, e2):
    a1r, a1i, b1r, b1i = e1
    a2r, a2i, b2r, b2i = e2
    ar = a2r * a1r - a2i * a1i
    ai = a2r * a1i + a2i * a1r
    br = a2r * b1r - a2i * b1i + b2r
    bi = a2r * b1i + a2i * b1r + b2i
    return (ar, ai, br, bi)


def _s5_mixer(u, lam_re, lam_im, log_dt, b_re, b_im, c_re, c_im, d_skip, w_glu, b_glu):
    bsz, seq, _ = u.shape
    ug = u.reshape(bsz, seq, SSM_GROUPS, SSM_GROUP).astype(jnp.float32)
    y = d_skip.astype(jnp.float32) * ug
    for direction in range(2):
        lr = lam_re[direction].astype(jnp.float32)
        li = lam_im[direction].astype(jnp.float32)
        dt = jnp.exp(log_dt[direction].astype(jnp.float32))[:, None]
        mag = jnp.exp(lr * dt)
        ab_re = mag * jnp.cos(li * dt)
        ab_im = mag * jnp.sin(li * dt)
        den = lr * lr + li * li
        nr = ab_re - 1.0
        f_re = (nr * lr + ab_im * li) / den
        f_im = (ab_im * lr - nr * li) / den
        bu_re = jnp.einsum('bsgc,gpc->bsgp', ug, b_re[direction].astype(jnp.float32))
        bu_im = jnp.einsum('bsgc,gpc->bsgp', ug, b_im[direction].astype(jnp.float32))
        x_re = f_re * bu_re - f_im * bu_im
        x_im = f_re * bu_im + f_im * bu_re
        a_re = jnp.broadcast_to(ab_re, x_re.shape)
        a_im = jnp.broadcast_to(ab_im, x_im.shape)
        _, _, s_re, s_im = lax.associative_scan(_complex_linear_combine, (a_re, a_im, x_re, x_im), axis=1, reverse=(direction == 1))
        y = y + jnp.einsum('bsgp,gcp->bsgc', s_re, c_re[direction].astype(jnp.float32)) - jnp.einsum('bsgp,gcp->bsgc', s_im, c_im[direction].astype(jnp.float32))
    z = jax.nn.gelu(y.reshape(bsz, seq, SSM_WIDTH)).astype(u.dtype)
    return z * jax.nn.sigmoid(z @ w_glu + b_glu)


def _moe(h, w_router, b_router, w_gate_up, b_gate_up, w_down, b_down):
    bsz, seq, d = h.shape
    t = bsz * seq
    xt = h.reshape(t, d)
    logits = (xt @ w_router + b_router).astype(jnp.float32)
    top_vals, top_idx = lax.top_k(logits, TOP_K)
    gate_w = jax.nn.softmax(top_vals, axis=-1)
    e_flat = top_idx.reshape(-1)
    w_flat = gate_w.reshape(-1)
    tok = jnp.repeat(jnp.arange(t, dtype=jnp.int32), TOP_K)
    order = jnp.argsort(e_flat)
    e_sorted = e_flat[order]
    counts = jnp.bincount(e_flat, length=N_EXPERTS)
    padded = ((counts + MOE_BLOCK - 1) // MOE_BLOCK) * MOE_BLOCK
    pad_end = jnp.cumsum(padded)
    pad_start = pad_end - padded
    start = jnp.cumsum(counts) - counts
    rank = jnp.arange(t * TOP_K) - start[e_sorted]
    dest = pad_start[e_sorted] + rank
    n_rows = (-(-(t * TOP_K) // MOE_BLOCK) + N_EXPERTS) * MOE_BLOCK
    n_blocks = n_rows // MOE_BLOCK
    row_tok = jnp.full((n_rows,), t, dtype=jnp.int32).at[dest].set(tok[order])
    row_w = jnp.zeros((n_rows,), dtype=h.dtype).at[dest].set(w_flat[order].astype(h.dtype))
    block_exp = jnp.minimum(jnp.searchsorted(pad_end, jnp.arange(n_blocks) * MOE_BLOCK, side='right'), N_EXPERTS - 1)
    x_pad = jnp.concatenate([xt, jnp.zeros((1, d), xt.dtype)], axis=0)
    xs = x_pad[row_tok].reshape(n_blocks, MOE_BLOCK, d)

    def expert_block(args):
        xb, e = args
        gu = xb @ w_gate_up[e] + b_gate_up[e]
        gate, up = gu[:, :D_EXPERT], gu[:, D_EXPERT:]
        gate = jnp.minimum(gate, SWIGLU_LIMIT)
        up = jnp.clip(up, -SWIGLU_LIMIT, SWIGLU_LIMIT)
        act = gate * jax.nn.sigmoid(SWIGLU_ALPHA * gate) * (up + 1.0)
        return act @ w_down[e] + b_down[e]

    ys = lax.map(expert_block, (xs, block_exp)).reshape(n_rows, d)
    out = jnp.zeros((t + 1, d), h.dtype).at[row_tok].add(ys * row_w[:, None])[:t]
    return out.reshape(bsz, seq, d)


def setup_inputs(seed: int = 0) -> dict:
    key = jax.random.key(seed)
    ks = jax.random.split(key, 26)
    f32 = jnp.float32
    G, P, C = SSM_GROUPS, SSM_STATE, SSM_GROUP

    def nrm(k, shape, scale):
        return jax.random.normal(k, shape, f32) * scale

    return {
        'x': nrm(ks[0], (BATCH, SEQ, D_MODEL), 1.0),
        'norm1': 1.0 + nrm(ks[1], (DEPTH, D_MODEL), 0.02),
        'w_in': nrm(ks[2], (DEPTH, D_MODEL, IN_WIDTH), D_MODEL ** -0.5),
        'q_norm': 1.0 + nrm(ks[3], (DEPTH, N_ATTN_HEADS, HEAD_DIM), 0.02),
        'k_norm': 1.0 + nrm(ks[4], (DEPTH, N_ATTN_HEADS, HEAD_DIM), 0.02),
        'lam_re': -0.5 * jnp.exp(nrm(ks[5], (DEPTH, 2, G, P), 0.05)),
        'lam_im': jnp.pi * jnp.arange(P, dtype=f32) + nrm(ks[6], (DEPTH, 2, G, P), 0.01),
        'log_dt': jax.random.uniform(ks[7], (DEPTH, 2, G), f32, math.log(DT_MIN), math.log(DT_MAX)),
        'b_re': nrm(ks[8], (DEPTH, 2, G, P, C), (2 * C) ** -0.5),
        'b_im': nrm(ks[9], (DEPTH, 2, G, P, C), (2 * C) ** -0.5),
        'c_re': nrm(ks[10], (DEPTH, 2, G, C, P), P ** -0.5),
        'c_im': nrm(ks[11], (DEPTH, 2, G, C, P), P ** -0.5),
        'd_skip': nrm(ks[12], (DEPTH, G, C), 1.0),
        'w_glu': nrm(ks[13], (DEPTH, SSM_WIDTH, SSM_WIDTH), SSM_WIDTH ** -0.5),
        'b_glu': nrm(ks[14], (DEPTH, SSM_WIDTH), 0.01),
        'w_attn_branch': nrm(ks[15], (DEPTH, ATTN_OUT_WIDTH, D_MODEL), ATTN_OUT_WIDTH ** -0.5),
        'w_ssm_branch': nrm(ks[16], (DEPTH, SSM_WIDTH, D_MODEL), SSM_WIDTH ** -0.5),
        'w_out': nrm(ks[17], (DEPTH, D_MODEL, D_MODEL), D_MODEL ** -0.5),
        'norm2': 1.0 + nrm(ks[18], (DEPTH, D_MODEL), 0.02),
        'w_router': nrm(ks[19], (DEPTH, D_MODEL, N_EXPERTS), D_MODEL ** -0.5),
        'b_router': nrm(ks[20], (DEPTH, N_EXPERTS), 0.01),
        'w_gate_up': nrm(ks[21], (DEPTH, N_EXPERTS, D_MODEL, 2 * D_EXPERT), D_MODEL ** -0.5),
        'b_gate_up': nrm(ks[22], (DEPTH, N_EXPERTS, 2 * D_EXPERT), 0.01),
        'w_down': nrm(ks[23], (DEPTH, N_EXPERTS, D_EXPERT, D_MODEL), D_EXPERT ** -0.5),
        'b_down': nrm(ks[24], (DEPTH, N_EXPERTS, D_MODEL), 0.01),
    }


def reference(x, norm1, w_in, q_norm, k_norm, lam_re, lam_im, log_dt, b_re, b_im, c_re, c_im, d_skip, w_glu, b_glu, w_attn_branch, w_ssm_branch, w_out, norm2, w_router, b_router, w_gate_up, b_gate_up, w_down, b_down):
    bsz, seq, _ = x.shape
    o_k = ATTN_WIDTH
    o_v = 2 * ATTN_WIDTH
    o_u = 3 * ATTN_WIDTH
    o_g = o_u + SSM_WIDTH
    for l in range(DEPTH):
        h = _rmsnorm(x, norm1[l])
        proj = h @ w_in[l]
        q = proj[..., :o_k].reshape(bsz, seq, N_ATTN_HEADS, HEAD_DIM)
        k = proj[..., o_k:o_v].reshape(bsz, seq, N_ATTN_HEADS, HEAD_DIM)
        v = proj[..., o_v:o_u].reshape(bsz, seq, N_ATTN_HEADS, HEAD_DIM)
        u = proj[..., o_u:o_g]
        gates = jax.nn.sigmoid(proj[..., o_g:].astype(jnp.float32)).astype(x.dtype).reshape(bsz, seq, N_BRANCHES, D_MODEL)
        q = _rope(_rmsnorm(q, q_norm[l]))
        k = _rope(_rmsnorm(k, k_norm[l]))
        y_attn = _dilated_attention_mixer(q, k, v) @ w_attn_branch[l]
        y_ssm = _s5_mixer(u, lam_re[l], lam_im[l], log_dt[l], b_re[l], b_im[l], c_re[l], c_im[l], d_skip[l], w_glu[l], b_glu[l]) @ w_ssm_branch[l]
        mixed = gates[:, :, 0] * y_attn + gates[:, :, 1] * y_ssm
        x = x + mixed @ w_out[l]
        x = x + _moe(_rmsnorm(x, norm2[l]), w_router[l], b_router[l], w_gate_up[l], b_gate_up[l], w_down[l], b_down[l])
    return x
```

```cpp
#include <hip/hip_runtime.h>
#include <cstdio>
#include <cstdint>

#ifndef MK_N_LAUNCHES
#define MK_N_LAUNCHES 0
#endif

#define GAS __attribute__((address_space(1)))
#define LAS __attribute__((address_space(3)))
typedef unsigned short bf16;
typedef short bf16x8 __attribute__((ext_vector_type(8)));
typedef short s16x4 __attribute__((ext_vector_type(4)));
typedef float f32x2 __attribute__((ext_vector_type(2)));
typedef float f32x4 __attribute__((ext_vector_type(4)));
typedef float f32x16 __attribute__((ext_vector_type(16)));
typedef unsigned u32x2 __attribute__((ext_vector_type(2)));
typedef unsigned u32x4 __attribute__((ext_vector_type(4)));
typedef __bf16 bf16x2_t __attribute__((ext_vector_type(2)));

constexpr int T = 32768, DM = 1024, SEQ = 16384, NH = 12, HD = 64, INW = 4864;
constexpr int SSMW = 512, NG = 32, GC = 16, NP = 64;
constexpr int CL = 64, NCH = T / CL  , CHB = SEQ / CL  , KA2 = 1280;
constexpr int NE = 32, TOPK = 4, RMAX = T * TOPK + NE * 256;
constexpr float NORM_EPS = 1e-6f;
constexpr float QSCALE = 0.125f * 1.4426950408889634f;
constexpr int NWAVES = 8, NTHREADS = 512;

constexpr size_t MiB = 1u << 20;
constexpr size_t WS_CTL = 0, CTL_ZERO_BYTES = 1 * MiB;
constexpr size_t WS_WGU = 1 * MiB;
constexpr size_t WS_WD = WS_WGU + 128 * MiB;
constexpr size_t WS_X1B = WS_WD + 64 * MiB;
constexpr size_t WS_ROUTE = WS_X1B + 64 * MiB;
constexpr size_t RT_RSTD2 = WS_ROUTE;
constexpr size_t RT_TOPI = RT_RSTD2 + 128 * 1024;
constexpr size_t RT_TOPW = RT_TOPI + 512 * 1024;
constexpr size_t RT_CNT = RT_TOPW + 512 * 1024;
constexpr size_t RT_META = RT_CNT + 32 * 1024;
constexpr size_t RT_ROWTOK = RT_META + 4096;
constexpr size_t RT_ROWDST = RT_ROWTOK + 576 * 1024;
constexpr size_t RT_ROWW = RT_ROWDST + 576 * 1024;
static_assert((size_t)RMAX * 4 <= 576 * 1024 && RT_ROWW + 576 * 1024 <= WS_ROUTE + 4 * MiB, "route map");
constexpr size_t WS_EARLY = WS_ROUTE + 4 * MiB;
constexpr size_t WS_WIN = WS_EARLY;
constexpr size_t WS_ROPE = WS_WIN + 10 * MiB;
constexpr size_t WS_POW = WS_ROPE + 4 * MiB;
constexpr size_t WS_AO = WS_WIN;
constexpr size_t WS_KT = WS_POW + 3 * MiB;
constexpr size_t WS_BF = WS_KT + 5 * MiB;
constexpr size_t WS_WSM = WS_BF + 1 * MiB;
constexpr size_t WS_WGLU = WS_WSM, WS_WA = WS_WSM + MiB / 2, WS_WS = WS_WSM + 1 * MiB, WS_WO = WS_WSM + 2 * MiB;
constexpr size_t WS_BT1 = WS_WSM + 4 * MiB;
constexpr size_t WS_E = WS_BT1 + 16 * MiB;
constexpr size_t WS_Z = WS_BT1;
constexpr size_t WS_BT2 = WS_E + 16 * MiB;
constexpr size_t WS_XB = WS_BT2 + 80 * MiB;
constexpr size_t WS_MIXED = WS_XB;
constexpr size_t WS_RSTD1 = WS_XB + 64 * MiB;
constexpr size_t WS_Q = WS_RSTD1 + 1 * MiB;
constexpr size_t WS_K = WS_Q + 48 * MiB;
constexpr size_t WS_V = WS_K + 48 * MiB;
constexpr size_t WS_T1 = WS_Q;
constexpr size_t WS_GLU = WS_V;
constexpr size_t WS_UA = WS_V + 48 * MiB;
constexpr size_t WS_GATES = WS_UA + 40 * MiB;
constexpr size_t WS_O = WS_GATES + 128 * MiB;
constexpr size_t WS_LSE = WS_O + 48 * MiB;
constexpr size_t WS_EARLY_END = WS_LSE + 2 * MiB;
constexpr size_t WS_ACT = WS_EARLY;
constexpr size_t WS_Y4 = WS_ACT + 272 * MiB;
constexpr size_t WS_END = (WS_EARLY_END > WS_Y4 + 256 * MiB) ? WS_EARLY_END : (WS_Y4 + 256 * MiB);
static_assert((size_t)RMAX * 2048 <= 272 * MiB, "ACT size");
static_assert(WS_END <= 1024 * MiB, "d_ws map must fit 1 GiB");

constexpr int CW_TMO = 0, CW_BAR = 4096;

constexpr int RING_BYTES = 131072, LDSX_OFF = RING_BYTES, MISC_OFF = LDSX_OFF + 320, TPRE_OFF = LDSX_OFF + 1024, LDS_BYTES = 147456;

#define RLX_AGENT __ATOMIC_RELAXED, __HIP_MEMORY_SCOPE_AGENT
#define LDS_WAIT() asm volatile("s_waitcnt lgkmcnt(0)" ::: "memory")
#define VM_WAIT() asm volatile("s_waitcnt vmcnt(0)" ::: "memory")
__device__ __forceinline__ unsigned f2bf(float f) { unsigned u = __builtin_bit_cast(unsigned, f); return (u + 0x7fffu + ((u >> 16) & 1u)) >> 16; }
__device__ __forceinline__ unsigned pk2(float lo, float hi) { f32x2 v = {lo, hi}; bf16x2_t b = __builtin_convertvector(v, bf16x2_t); return __builtin_bit_cast(unsigned, b); }
__device__ __forceinline__ float bflo(unsigned w) { return __builtin_bit_cast(float, w << 16); }
__device__ __forceinline__ float bfhi(unsigned w) { return __builtin_bit_cast(float, w & 0xffff0000u); }
__device__ __forceinline__ float bf2f(bf16 b) { return __builtin_bit_cast(float, (unsigned)b << 16); }
__device__ __forceinline__ float sigmoidf_(float x) { return 1.0f / (1.0f + __expf(-x)); }
__device__ __forceinline__ float gelu_tanh(float x) { const float u = 0.7978845608028654f * (x + 0.044715f * x * x * x); return x * sigmoidf_(2.0f * u); }
__device__ __forceinline__ float wave_sum(float v) {
#pragma unroll
    for (int o = 1; o < 64; o <<= 1) v += __shfl_xor(v, o);
    return v;
}

namespace pg8 {
constexpr int BM = 256, BK = 64, HALF = 128, HTB = HALF * BK * 2, STAGE_BYTES = 8 * HTB;
__host__ __device__ __forceinline__ int lds_byte(int r, int c) { const int st = (r >> 4) * 2 + (c >> 5), rr = r & 15, cc = c & 31, ob = rr * 64 + cc * 2; return st * 1024 + (ob ^ (((ob >> 9) & 1) << 5)); }
__host__ __device__ __forceinline__ void stage_rc(int b, int& R, int& C) { const int st = b / 1024, sb = b % 1024, swz = sb ^ (((sb >> 9) & 1) << 5); R = (st >> 1) * 16 + swz / 64; C = (st & 1) * 32 + (swz % 64) / 2; }
__host__ __device__ __forceinline__ int perm32(int rho) { const int n = rho >> 4, i = rho & 15; return 8 * (i >> 2) + 4 * n + (i & 3); }

struct Unit { int pm, pn, e, row0; };

__device__ __forceinline__ bool static_order(int nM, int nN, int G, int c, int i, int& pm, int& pn) {
    const int nwg = nM * nN; const long L = (long)i * G + c; if (L >= nwg) return false;
    int wgid = (int)L; { const int q = nwg / 8, r = nwg % 8, xcd = wgid % 8, off = wgid / 8; wgid = (xcd < r ? xcd * (q + 1) : r * (q + 1) + (xcd - r) * q) + off; }
    const int nig = 8 * nN, gid = wgid / nig, fm = gid * 8, gsz = (nM - fm) < 8 ? (nM - fm) : 8;
    pm = fm + ((wgid % nig) % gsz); pn = (wgid % nig) / gsz; return true;
}

template <class P>
__device__ __forceinline__ void gemm_phase(LAS unsigned char* lds, const P& p) {
    const int tid = threadIdx.x, wid = __builtin_amdgcn_readfirstlane(tid >> 6), lane = tid & 63, wr = wid >> 2, wc = wid & 3, fr = lane & 15, fq = lane >> 4;
    const int K = p.K, nt = K / BK;
    int R0, C0, R1, C1; stage_rc(tid * 16, R0, C0); stage_rc(tid * 16 + 8192, R1, C1);
    unsigned voffB[2], vA0[2], vA1[2];
    { const int Rb0 = P::PERM ? ((R0 & ~31) + perm32(R0 & 31)) : R0, Rb1 = P::PERM ? ((R1 & ~31) + perm32(R1 & 31)) : R1;
      voffB[0] = (unsigned)(Rb0 * K + C0) * 2u; voffB[1] = (unsigned)(Rb1 * K + C1) * 2u; }
    const size_t kstep = (size_t)(BK * 2);
    const size_t hstepB = (size_t)HALF * K * 2;
    const unsigned ldsw = (unsigned)wid * 1024u;
    const int aoff = lds_byte(wr * 64 + fr, fq * 8), boff = lds_byte(wc * 32 + fr, fq * 8);
#define PG8_SA(b, h) (((b) * 2 + (h)) * HTB)
#define PG8_SB(b, h) ((4 + (b) * 2 + (h)) * HTB)
#define PG8_STAGE(bufoff, gbase, voff) do { _Pragma("unroll") for (int _i = 0; _i < 2; ++_i) \
        __builtin_amdgcn_global_load_lds((const unsigned*)((const char*)(gbase) + (voff)[_i]), (LAS unsigned*)(lds + (bufoff) + ldsw + _i * 8192), 16, 0, 0); } while (0)
#define PG8_LDA(dst, b, h) do { _Pragma("unroll") for (int m = 0; m < 4; ++m) _Pragma("unroll") for (int k = 0; k < 2; ++k) dst[m][k] = *(const LAS bf16x8*)(lds + PG8_SA(b, h) + aoff + m * 2048 + k * 1024); } while (0)
#define PG8_LDB(dst, b, h) do { _Pragma("unroll") for (int n = 0; n < 2; ++n) _Pragma("unroll") for (int k = 0; k < 2; ++k) dst[n][k] = *(const LAS bf16x8*)(lds + PG8_SB(b, h) + boff + n * 2048 + k * 1024); } while (0)
#define PG8_MMA(ai, bj, At, Bt) do { __builtin_amdgcn_s_setprio(1); _Pragma("unroll") for (int m = 0; m < 4; ++m) _Pragma("unroll") for (int n = 0; n < 2; ++n) _Pragma("unroll") for (int k = 0; k < 2; ++k) \
        acc[ai][bj][m][n] = __builtin_amdgcn_mfma_f32_16x16x32_bf16(Bt[n][k], At[m][k], acc[ai][bj][m][n], 0, 0, 0); __builtin_amdgcn_s_setprio(0); } while (0)
#define PG8_WAIT_V(n) asm volatile("s_waitcnt vmcnt(" #n ")" ::: "memory")
#define PG8_WAIT_L(n) asm volatile("s_waitcnt lgkmcnt(" #n ")" ::: "memory")
#define PG8_BAR __builtin_amdgcn_s_barrier()
#define PG8_SCHED __builtin_amdgcn_sched_barrier(0)
    Unit cur, nxt; int ui = 0;
    if (!p.next(0, cur)) return;
    f32x4 acc[2][2][4][2];
#pragma unroll
    for (int a = 0; a < 2; ++a)
#pragma unroll
        for (int b = 0; b < 2; ++b)
#pragma unroll
            for (int m = 0; m < 4; ++m)
#pragma unroll
                for (int n = 0; n < 2; ++n) acc[a][b][m][n] = (f32x4){0.f, 0.f, 0.f, 0.f};
    bf16x8 At[4][2], B0[2][2], B1[2][2];
    const char* cA = p.a_base(cur); const char* cB = p.b_base(cur);
    p.a_voff(cur, R0, R1, C0, C1, vA0, vA1);
    PG8_STAGE(PG8_SB(0, 0), cB, voffB); PG8_STAGE(PG8_SB(0, 1), cB + hstepB, voffB); PG8_STAGE(PG8_SA(0, 0), cA, vA0); PG8_STAGE(PG8_SA(0, 1), cA, vA1);
    if (wr == 1) PG8_BAR;
    PG8_WAIT_V(2); PG8_BAR;
    PG8_STAGE(PG8_SB(1, 0), cB + kstep, voffB); PG8_STAGE(PG8_SA(1, 0), cA + kstep, vA0); PG8_STAGE(PG8_SB(1, 1), cB + hstepB + kstep, voffB);
    PG8_WAIT_V(6); PG8_BAR;
    for (;;) {
        const bool has_next = p.next(ui + 1, nxt);
        const char* nA = has_next ? p.a_base(nxt) : cA; const char* nB = has_next ? p.b_base(nxt) : cB;
        for (int t = 0; t < nt; t += 2) {
            const bool last = (t == nt - 2);
            const char* a1 = cA + (size_t)(t + 1) * kstep;
            const char* a2 = last ? nA : cA + (size_t)(t + 2) * kstep; const char* b2 = last ? nB : cB + (size_t)(t + 2) * kstep;
            const char* a3 = a2 + kstep; const char* b3 = b2 + kstep;
            PG8_LDB(B0, 0, 0); PG8_LDB(B1, 0, 1); PG8_SCHED; PG8_LDA(At, 0, 0); PG8_STAGE(PG8_SA(1, 1), a1, vA1);
            if (last && has_next) p.a_voff(nxt, R0, R1, C0, C1, vA0, vA1);
            PG8_WAIT_V(8); PG8_WAIT_L(0); PG8_BAR; PG8_MMA(0, 0, At, B0); PG8_MMA(0, 1, At, B1); PG8_BAR; PG8_SCHED;
            PG8_LDA(At, 0, 1); PG8_STAGE(PG8_SB(0, 0), b2, voffB); PG8_STAGE(PG8_SB(0, 1), b2 + hstepB, voffB); PG8_STAGE(PG8_SA(0, 0), a2, vA0);
            PG8_WAIT_V(8); PG8_WAIT_L(0); PG8_BAR; PG8_MMA(1, 0, At, B0); PG8_MMA(1, 1, At, B1); PG8_BAR; PG8_SCHED;
            PG8_LDB(B0, 1, 0); PG8_LDB(B1, 1, 1); PG8_SCHED; PG8_LDA(At, 1, 0); PG8_STAGE(PG8_SA(0, 1), a2, vA1);
            PG8_WAIT_V(8); PG8_WAIT_L(0); PG8_BAR; PG8_MMA(0, 0, At, B0); PG8_MMA(0, 1, At, B1); PG8_BAR; PG8_SCHED;
            PG8_LDA(At, 1, 1); PG8_STAGE(PG8_SB(1, 0), b3, voffB); PG8_STAGE(PG8_SB(1, 1), b3 + hstepB, voffB); PG8_STAGE(PG8_SA(1, 0), a3, vA0);
            PG8_WAIT_V(8); PG8_WAIT_L(0); PG8_BAR; PG8_MMA(1, 0, At, B0); PG8_MMA(1, 1, At, B1); PG8_BAR; PG8_SCHED;
        }
        if (wr == 0) PG8_BAR;
        p.epi(acc, cur, wr, wc, fr, fq);
        if (!has_next) break;
#pragma unroll
        for (int a = 0; a < 2; ++a)
#pragma unroll
            for (int b = 0; b < 2; ++b)
#pragma unroll
                for (int m = 0; m < 4; ++m)
#pragma unroll
                    for (int n = 0; n < 2; ++n) acc[a][b][m][n] = (f32x4){0.f, 0.f, 0.f, 0.f};
        cur = nxt; cA = nA; cB = nB; ++ui;
        if (wr == 1) PG8_BAR;
    }
    PG8_WAIT_V(0);
    PG8_BAR;
#undef PG8_SA
#undef PG8_SB
#undef PG8_STAGE
#undef PG8_LDA
#undef PG8_LDB
#undef PG8_MMA
#undef PG8_WAIT_V
#undef PG8_WAIT_L
#undef PG8_BAR
#undef PG8_SCHED
}
}
using pg8::Unit;
typedef f32x4 AccT[2][2][4][2];

struct DenseA {
    const bf16* A; int lda;
    __device__ __forceinline__ const char* base(int pm) const { return (const char*)A + (size_t)pm * 256 * lda * 2; }
    __device__ __forceinline__ void voff(int R0, int R1, int C0, int C1, unsigned* v0, unsigned* v1) const {
        v0[0] = (unsigned)(R0 * lda + C0) * 2u; v0[1] = (unsigned)(R1 * lda + C1) * 2u; v1[0] = v0[0] + (unsigned)(128 * lda * 2); v1[1] = v0[1] + (unsigned)(128 * lda * 2); }
};
__device__ __forceinline__ u32x4 pack8(const f32x4& a, const f32x4& b) { u32x4 w; w.x = pk2(a[0], a[1]); w.y = pk2(a[2], a[3]); w.z = pk2(b[0], b[1]); w.w = pk2(b[2], b[3]); return w; }
__device__ __forceinline__ void unpack8(const u32x4& w, f32x4& a, f32x4& b) { a = (f32x4){bflo(w.x), bfhi(w.x), bflo(w.y), bfhi(w.y)}; b = (f32x4){bflo(w.z), bfhi(w.z), bflo(w.w), bfhi(w.w)}; }
#define EPI_FENCE() asm volatile("" ::: "memory")

struct PolG1 {
    static constexpr bool PERM = true;
    int K, G, c;
    const bf16* XB; const bf16* WT; const float* rstd1; const float* qn; const float* kn; const float* rope;
    bf16 *Q, *Kb, *V, *UA, *GT;
    __device__ __forceinline__ bool next(int i, Unit& u) const { u.e = 0; u.row0 = 0; return pg8::static_order(128, 19, G, c, i, u.pm, u.pn); }
    __device__ __forceinline__ int tok0(const Unit& u, int& sh) const {
        if (u.pn >= 9) { sh = 0; return u.pm * 256; }
        sh = 2 * (u.pn % 3); const int pr0 = u.pm * 256, b = pr0 >> 14, q = pr0 & 16383, rr = q >> (14 - sh), i0 = q & ((16384 >> sh) - 1);
        return (b << 14) + (i0 << sh) + rr;
    }
    __device__ __forceinline__ const char* a_base(const Unit& u) const { int sh; const int t0 = tok0(u, sh); return (const char*)XB + (size_t)t0 * 2048; }
    __device__ __forceinline__ void a_voff(const Unit& u, int R0, int R1, int C0, int C1, unsigned* v0, unsigned* v1) const {
        int sh; (void)tok0(u, sh); const unsigned rs = 2048u << sh;
        v0[0] = (unsigned)R0 * rs + (unsigned)C0 * 2u; v0[1] = (unsigned)R1 * rs + (unsigned)C1 * 2u; v1[0] = v0[0] + 128u * rs; v1[1] = v0[1] + 128u * rs; }
    __device__ __forceinline__ const char* b_base(const Unit& u) const { return (const char*)WT + (size_t)u.pn * 256 * 1024 * 2; }
    __device__ __forceinline__ void epi(AccT& acc, const Unit& u, int wr, int wc, int fr, int fq) const {
        int sh; const int t0 = tok0(u, sh);
        if (u.pn < 6) {
            const int g = u.pn % 3, head = 4 * g + wc; const bool isq = u.pn < 3;
            const float* gain = (isq ? qn : kn) + head * 64; const float sc = isq ? QSCALE : 1.0f;
            bf16* dst = (isq ? Q : Kb) + (size_t)head * T * 64;
            f32x4 gv[2][2];
#pragma unroll
            for (int bj = 0; bj < 2; ++bj)
#pragma unroll
                for (int n = 0; n < 2; ++n) gv[bj][n] = *(const f32x4*)(gain + 32 * bj + 8 * fq + 4 * n);
#pragma unroll
            for (int ai = 0; ai < 2; ++ai)
#pragma unroll
                for (int m = 0; m < 4; ++m) {
                    const int r = 128 * ai + 64 * wr + 16 * m + fr, token = t0 + (r << sh), prow = u.pm * 256 + r; const float rs = rstd1[token];
                    f32x4 x[2][2]; float ss = 0.f;
#pragma unroll
                    for (int bj = 0; bj < 2; ++bj)
#pragma unroll
                        for (int n = 0; n < 2; ++n) { x[bj][n] = acc[ai][bj][m][n] * rs; const f32x4 q2 = x[bj][n] * x[bj][n]; ss += (q2[0] + q2[1]) + (q2[2] + q2[3]); }
                    ss += __shfl_xor(ss, 16); ss += __shfl_xor(ss, 32);
                    const float rn = rsqrtf(ss * (1.0f / 64.0f) + NORM_EPS) * sc;
                    const int pos = token & 16383; const f32x4* rp = (const f32x4*)(rope + ((size_t)pos * 32 + 8 * fq) * 2);
                    f32x4 olo[2], ohi[2];
#pragma unroll
                    for (int n = 0; n < 2; ++n) {
                        const f32x4 cs0 = rp[2 * n], cs1 = rp[2 * n + 1];
                        const f32x4 cv = {cs0[0], cs0[2], cs1[0], cs1[2]}, sv = {cs0[1], cs0[3], cs1[1], cs1[3]};
                        const f32x4 lo = x[0][n] * gv[0][n] * rn, hi = x[1][n] * gv[1][n] * rn;
                        olo[n] = lo * cv - hi * sv; ohi[n] = hi * cv + lo * sv;
                    }
                    bf16* rowp = dst + (size_t)prow * 64 + 8 * fq;
                    *(u32x4*)rowp = pack8(olo[0], olo[1]); *(u32x4*)(rowp + 32) = pack8(ohi[0], ohi[1]);
                    if (m & 1) EPI_FENCE();
                }
        } else if (u.pn < 9) {
            const int g = u.pn % 3, head = 4 * g + wc; bf16* dst = V + (size_t)head * T * 64;
#pragma unroll
            for (int ai = 0; ai < 2; ++ai)
#pragma unroll
                for (int m = 0; m < 4; ++m) {
                    const int r = 128 * ai + 64 * wr + 16 * m + fr, token = t0 + (r << sh), prow = u.pm * 256 + r; const float rs = rstd1[token];
                    bf16* rowp = dst + (size_t)prow * 64 + 8 * fq;
#pragma unroll
                    for (int bj = 0; bj < 2; ++bj) *(u32x4*)(rowp + 32 * bj) = pack8(acc[ai][bj][m][0] * rs, acc[ai][bj][m][1] * rs);
                }
        } else if (u.pn < 11) {
#pragma unroll
            for (int ai = 0; ai < 2; ++ai)
#pragma unroll
                for (int m = 0; m < 4; ++m) {
                    const int r = 128 * ai + 64 * wr + 16 * m + fr, token = t0 + r; const float rs = rstd1[token];
#pragma unroll
                    for (int bj = 0; bj < 2; ++bj) { const int col0 = 256 * (u.pn - 9) + 128 * bj + 32 * wc + 8 * fq, gq = col0 >> 4, ch0 = col0 & 15;
                        *(u32x4*)(UA + ((size_t)(gq * NCH + (token >> 6)) * KA2 + (token & 63) * 16 + ch0)) = pack8(acc[ai][bj][m][0] * rs, acc[ai][bj][m][1] * rs); }
                }
        } else {
#pragma unroll
            for (int ai = 0; ai < 2; ++ai)
#pragma unroll
                for (int m = 0; m < 4; ++m) {
                    const int r = 128 * ai + 64 * wr + 16 * m + fr, token = t0 + r; const float rs = rstd1[token];
#pragma unroll
                    for (int bj = 0; bj < 2; ++bj) { const int col0 = 256 * (u.pn - 11) + 128 * bj + 32 * wc + 8 * fq; f32x4 a = acc[ai][bj][m][0] * rs, b = acc[ai][bj][m][1] * rs;
#pragma unroll
                        for (int i = 0; i < 4; ++i) { a[i] = sigmoidf_(a[i]); b[i] = sigmoidf_(b[i]); }
                        *(u32x4*)(GT + (size_t)token * 2048 + col0) = pack8(a, b); }
                }
        }
    }
};

struct PolS5a {
    static constexpr bool PERM = false;
    int K, G, c; const bf16* UA; const bf16* BT1; float* E;
    __device__ __forceinline__ bool next(int i, Unit& u) const { const int L = i * G + c; if (L >= 64) return false; u.e = L >> 1; u.pm = L & 1; u.pn = 0; u.row0 = 0; return true; }
    __device__ __forceinline__ const char* a_base(const Unit& u) const { return (const char*)UA + (size_t)(u.e * NCH + u.pm * 256) * KA2 * 2; }
    __device__ __forceinline__ void a_voff(const Unit&, int R0, int R1, int C0, int C1, unsigned* v0, unsigned* v1) const { DenseA d{nullptr, KA2}; d.voff(R0, R1, C0, C1, v0, v1); }
    __device__ __forceinline__ const char* b_base(const Unit& u) const { return (const char*)BT1 + (size_t)u.e * 256 * 1024 * 2; }
    __device__ __forceinline__ void epi(AccT& acc, const Unit& u, int wr, int wc, int fr, int fq) const {
#pragma unroll
        for (int ai = 0; ai < 2; ++ai)
#pragma unroll
            for (int m = 0; m < 4; ++m) { const int r = 128 * ai + 64 * wr + 16 * m + fr; float* rowp = E + (size_t)(u.e * NCH + u.pm * 256 + r) * 256 + 32 * wc + 4 * fq;
#pragma unroll
                for (int bj = 0; bj < 2; ++bj)
#pragma unroll
                    for (int n = 0; n < 2; ++n) *(f32x4*)(rowp + 128 * bj + 16 * n) = acc[ai][bj][m][n]; }
    }
};
struct PolS5b {
    static constexpr bool PERM = true;
    int K, G, vcu; const bf16* UA; const bf16* BT2; bf16* Z;
    __device__ __forceinline__ bool next(int i, Unit& u) const { const int L = i * G + vcu; if (L >= 256) return false; u.e = L >> 3; u.pm = (L >> 2) & 1; u.pn = L & 3; u.row0 = 0; return true; }
    __device__ __forceinline__ const char* a_base(const Unit& u) const { return (const char*)UA + (size_t)(u.e * NCH + u.pm * 256) * KA2 * 2; }
    __device__ __forceinline__ void a_voff(const Unit&, int R0, int R1, int C0, int C1, unsigned* v0, unsigned* v1) const { DenseA d{nullptr, KA2}; d.voff(R0, R1, C0, C1, v0, v1); }
    __device__ __forceinline__ const char* b_base(const Unit& u) const { return (const char*)BT2 + (size_t)(u.e * 1024 + u.pn * 256) * KA2 * 2; }
    __device__ __forceinline__ void epi(AccT& acc, const Unit& u, int wr, int wc, int fr, int fq) const {
#pragma unroll
        for (int ai = 0; ai < 2; ++ai)
#pragma unroll
            for (int m = 0; m < 4; ++m) { const int r = 128 * ai + 64 * wr + 16 * m + fr, chunk = u.pm * 256 + r;
#pragma unroll
                for (int bj = 0; bj < 2; ++bj) { const int tl = 16 * u.pn + 8 * bj + 2 * wc + (fq >> 1), c0 = 8 * (fq & 1); f32x4 a = acc[ai][bj][m][0], b = acc[ai][bj][m][1];
#pragma unroll
                    for (int i = 0; i < 4; ++i) { a[i] = gelu_tanh(a[i]); b[i] = gelu_tanh(b[i]); }
                    *(u32x4*)(Z + (size_t)(chunk * 64 + tl) * SSMW + u.e * 16 + c0) = pack8(a, b); } }
    }
};
template <int KIND> struct PolDense {
    static constexpr bool PERM = (KIND != 3);
    int K, G, c, nN; DenseA A; const bf16* Bt;
    const bf16* in0; const bf16* in1; const float* fin; const float* bias; bf16* o16; float* o32;
    __device__ __forceinline__ bool next(int i, Unit& u) const { u.e = 0; u.row0 = 0; return pg8::static_order(128, nN, G, c, i, u.pm, u.pn); }
    __device__ __forceinline__ const char* a_base(const Unit& u) const { return A.base(u.pm); }
    __device__ __forceinline__ void a_voff(const Unit&, int R0, int R1, int C0, int C1, unsigned* v0, unsigned* v1) const { A.voff(R0, R1, C0, C1, v0, v1); }
    __device__ __forceinline__ const char* b_base(const Unit& u) const { return (const char*)Bt + (size_t)u.pn * 256 * K * 2; }
    __device__ __forceinline__ void epi(AccT& acc, const Unit& u, int wr, int wc, int fr, int fq) const {
#pragma unroll
        for (int ai = 0; ai < 2; ++ai)
#pragma unroll
            for (int m = 0; m < 4; ++m) { const int row = u.pm * 256 + 128 * ai + 64 * wr + 16 * m + fr;
#pragma unroll
                for (int bj = 0; bj < 2; ++bj) {
                    if constexpr (KIND == 0) {
                        const int col = u.pn * 256 + 128 * bj + 32 * wc + 8 * fq; f32x4 za, zb; unpack8(*(const u32x4*)(in0 + (size_t)row * SSMW + col), za, zb);
                        f32x4 a = acc[ai][bj][m][0] + *(const f32x4*)(bias + col), b = acc[ai][bj][m][1] + *(const f32x4*)(bias + col + 4);
#pragma unroll
                        for (int i = 0; i < 4; ++i) { a[i] = za[i] * sigmoidf_(a[i]); b[i] = zb[i] * sigmoidf_(b[i]); }
                        *(u32x4*)(o16 + (size_t)row * SSMW + col) = pack8(a, b);
                    } else if constexpr (KIND == 1) {
                        const int col = u.pn * 256 + 128 * bj + 32 * wc + 8 * fq; f32x4 ga, gb; unpack8(*(const u32x4*)(in0 + (size_t)row * 2048 + col), ga, gb);
                        *(u32x4*)(o16 + (size_t)row * DM + col) = pack8(acc[ai][bj][m][0] * ga, acc[ai][bj][m][1] * gb);
                    } else if constexpr (KIND == 2) {
                        const int col = u.pn * 256 + 128 * bj + 32 * wc + 8 * fq; f32x4 ga, gb, ta, tb; unpack8(*(const u32x4*)(in0 + (size_t)row * 2048 + 1024 + col), ga, gb); unpack8(*(const u32x4*)(in1 + (size_t)row * DM + col), ta, tb);
                        *(u32x4*)(o16 + (size_t)row * DM + col) = pack8(ta + acc[ai][bj][m][0] * ga, tb + acc[ai][bj][m][1] * gb);
                    } else {
#pragma unroll
                        for (int n = 0; n < 2; ++n) { const int col = u.pn * 256 + 128 * bj + 32 * wc + 16 * n + 4 * fq; const f32x4 v = *(const f32x4*)(fin + (size_t)row * DM + col) + acc[ai][bj][m][n];
                            *(f32x4*)(o32 + (size_t)row * DM + col) = v; u32x2 w; w.x = pk2(v[0], v[1]); w.y = pk2(v[2], v[3]); *(u32x2*)(o16 + (size_t)row * DM + col) = w; }
                    }
                }
                if (m & 1) EPI_FENCE(); }
    }
};
__device__ __forceinline__ bool moe_next(const LAS int* tp, int npn_log, int G, int vcu, int i, Unit& u) {
    const int L = i * G + vcu, tiles = tp[32]; if (L >= (tiles << npn_log)) return false;
    const int tile = L >> npn_log; u.pn = L & ((1 << npn_log) - 1); int e = 0;
#pragma unroll 1
    for (int k = 1; k < 32; ++k) e += (tile >= tp[k]) ? 1 : 0;
    u.e = e; u.pm = tile - tp[e]; u.row0 = tile * 256; return true;
}
struct PolMoeGU {
    static constexpr bool PERM = true;
    int K, G, vcu; const LAS int* tp; const bf16* X1B; const bf16* WGU; const int* rowtok; const float* rstd2; const float* bgu; bf16* ACT;
    __device__ __forceinline__ bool next(int i, Unit& u) const { return moe_next(tp, 3, G, vcu, i, u); }
    __device__ __forceinline__ const char* a_base(const Unit&) const { return (const char*)X1B; }
    __device__ __forceinline__ void a_voff(const Unit& u, int R0, int R1, int C0, int C1, unsigned* v0, unsigned* v1) const {
        const int* rt = rowtok + u.row0;
        v0[0] = (unsigned)rt[R0] * 2048u + (unsigned)C0 * 2u; v0[1] = (unsigned)rt[R1] * 2048u + (unsigned)C1 * 2u;
        v1[0] = (unsigned)rt[128 + R0] * 2048u + (unsigned)C0 * 2u; v1[1] = (unsigned)rt[128 + R1] * 2048u + (unsigned)C1 * 2u; }
    __device__ __forceinline__ const char* b_base(const Unit& u) const { return (const char*)WGU + (size_t)(u.e * 2048 + u.pn * 256) * 1024 * 2; }
    __device__ __forceinline__ void epi(AccT& acc, const Unit& u, int wr, int wc, int fr, int fq) const {
        const int colg = u.pn * 128 + 32 * wc + 8 * fq; const float* bg = bgu + (size_t)u.e * 2048 + colg;
        const f32x4 bg0 = *(const f32x4*)bg, bg1 = *(const f32x4*)(bg + 4), bu0 = *(const f32x4*)(bg + 1024), bu1 = *(const f32x4*)(bg + 1028);
#pragma unroll
        for (int ai = 0; ai < 2; ++ai)
#pragma unroll
            for (int m = 0; m < 4; ++m) { const int row = u.row0 + 128 * ai + 64 * wr + 16 * m + fr; const float rs = rstd2[rowtok[row]];
                f32x4 ga = acc[ai][0][m][0] * rs + bg0, gb = acc[ai][0][m][1] * rs + bg1, ua = acc[ai][1][m][0] * rs + bu0, ub = acc[ai][1][m][1] * rs + bu1;
#pragma unroll
                for (int i = 0; i < 4; ++i) { float g1 = fminf(ga[i], 7.0f), u1 = fminf(fmaxf(ua[i], -7.0f), 7.0f); ga[i] = g1 * sigmoidf_(1.702f * g1) * (u1 + 1.0f);
                                              float g2 = fminf(gb[i], 7.0f), u2 = fminf(fmaxf(ub[i], -7.0f), 7.0f); gb[i] = g2 * sigmoidf_(1.702f * g2) * (u2 + 1.0f); }
                *(u32x4*)(ACT + (size_t)row * 1024 + colg) = pack8(ga, gb);
                if (m & 1) EPI_FENCE(); }
    }
};
struct PolMoeDN {
    static constexpr bool PERM = true;
    int K, G, vcu; const LAS int* tp; const bf16* ACT; const bf16* WD; const int* rowdst; const float* roww; const float* bd; bf16* Y4;
    __device__ __forceinline__ bool next(int i, Unit& u) const { return moe_next(tp, 2, G, vcu, i, u); }
    __device__ __forceinline__ const char* a_base(const Unit& u) const { return (const char*)ACT + (size_t)u.row0 * 2048; }
    __device__ __forceinline__ void a_voff(const Unit&, int R0, int R1, int C0, int C1, unsigned* v0, unsigned* v1) const { DenseA d{nullptr, 1024}; d.voff(R0, R1, C0, C1, v0, v1); }
    __device__ __forceinline__ const char* b_base(const Unit& u) const { return (const char*)WD + (size_t)(u.e * 1024 + u.pn * 256) * 1024 * 2; }
    __device__ __forceinline__ void epi(AccT& acc, const Unit& u, int wr, int wc, int fr, int fq) const {
#pragma unroll
        for (int ai = 0; ai < 2; ++ai)
#pragma unroll
            for (int m = 0; m < 4; ++m) { const int row = u.row0 + 128 * ai + 64 * wr + 16 * m + fr; const int dst = rowdst[row]; const float w = roww[row];
                if (dst >= 0) {
#pragma unroll
                    for (int bj = 0; bj < 2; ++bj) { const int col = u.pn * 256 + 128 * bj + 32 * wc + 8 * fq; const float* bb = bd + (size_t)u.e * 1024 + col;
                        *(u32x4*)(Y4 + (size_t)dst * 1024 + col) = pack8((acc[ai][bj][m][0] + *(const f32x4*)bb) * w, (acc[ai][bj][m][1] + *(const f32x4*)(bb + 4)) * w); } }
                if (m & 1) EPI_FENCE(); }
    }
};

struct Args { const float* in[25]; float* out; unsigned char* ws; int ph_lo, ph_hi; };
enum { I_X = 0, I_NORM1, I_WIN, I_QN, I_KN, I_LRE, I_LIM, I_LDT, I_BRE, I_BIM, I_CRE, I_CIM, I_DSK, I_WGLU, I_BGLU, I_WA, I_WS, I_WO, I_NORM2, I_WR, I_BR, I_WGU, I_BGU, I_WD, I_BD };

__device__ __forceinline__ int tr_dstrow(int mode, int n) {
    if (mode == 1) { if (n >= 2304) return n; const int pn = n >> 8, np = n & 255, hh = np >> 6, dd = np & 63; return (pn << 8) + 128 * (dd >> 5) + 32 * hh + (dd & 31); }
    if (mode == 2) { if (n < 1024) return ((n >> 7) << 8) + (n & 127); const int u = n - 1024; return ((u >> 7) << 8) + 128 + (u & 127); }
    return n;
}
__device__ __forceinline__ void p0_transpose_item(const float* W, int K, int N, bf16* WT, int mode, const float* ksc, LAS float* scr, int item, int lane) {
    const int nblk = N / 32, kb = item / nblk, nb = item % nblk, k0 = 64 * kb, n0 = 32 * nb;
#pragma unroll 8
    for (int i = 0; i < 32; ++i) { const int kk = 2 * i + (lane >> 5); float v = W[(size_t)(k0 + kk) * N + n0 + (lane & 31)]; if (ksc) v *= ksc[k0 + kk]; scr[kk * 33 + (lane & 31)] = v; }
    LDS_WAIT(); asm volatile("" ::: "memory");
    const int c = lane & 7;
#pragma unroll
    for (int j = 0; j < 4; ++j) { const int n = (lane >> 3) + 8 * j; const LAS float* s = scr + (8 * c) * 33 + n;
        u32x4 o; o.x = pk2(s[0 * 33], s[1 * 33]); o.y = pk2(s[2 * 33], s[3 * 33]); o.z = pk2(s[4 * 33], s[5 * 33]); o.w = pk2(s[6 * 33], s[7 * 33]);
        *(u32x4*)(WT + (size_t)tr_dstrow(mode, n0 + n) * K + k0 + 8 * c) = o; }
    LDS_WAIT(); asm volatile("" ::: "memory");
}
__device__ __forceinline__ void s5_mode(const Args& a, int g, int dir, int p, double& lr, double& li, double& dt) {
    const int gi = dir * NG + g; dt = exp((double)a.in[I_LDT][gi]); lr = (double)a.in[I_LRE][gi * NP + p]; li = (double)a.in[I_LIM][gi * NP + p];
}
__device__ __forceinline__ void p0_prologue(const Args& a, LAS unsigned char* lds, int tid, int lane, int wave, int vcu, int G) {
    unsigned char* ws = a.ws;
    const int gw = vcu * NWAVES + wave, NGW = G * NWAVES, gt = vcu * NTHREADS + tid, NT = G * NTHREADS;
    {
        const int g = vcu >> 3, s = vcu & 7;
        LAS f32x2* Cc = (LAS f32x2*)lds;
        LAS f32x2* Bf = (LAS f32x2*)(lds + 16384);
        LAS f32x2* Pw = (LAS f32x2*)(lds + 32768);
        LAS f32x2* Fm = (LAS f32x2*)(lds + 32768 + 8192);
        if (vcu < 256) {
            for (int i = tid; i < 2048; i += NTHREADS) { const int dir = i >> 10, c = (i >> 6) & 15, p = i & 63; const int src = ((dir * NG + g) * GC + c) * NP + p; Cc[i] = (f32x2){a.in[I_CRE][src], a.in[I_CIM][src]}; }
            if (tid < 128) { const int dir = tid >> 6, p = tid & 63; double lr, li, dt; s5_mode(a, g, dir, p, lr, li, dt);
                const double mag = exp(lr * dt), ar = mag * cos(li * dt), ai = mag * sin(li * dt), nr = ar - 1.0, den = lr * lr + li * li;
                Fm[tid] = (f32x2){(float)((nr * lr + ai * li) / den), (float)((ai * lr - nr * li) / den)}; }
            for (int i = tid; i < 1024; i += NTHREADS) { const int k = i >> 6, p = i & 63, ts = 16 * s + k - 63, dir = ts >= 0 ? 0 : 1, e = ts >= 0 ? ts : -ts;
                double lr, li, dt; s5_mode(a, g, dir, p, lr, li, dt); const double mag = exp(lr * dt * e), ang = li * dt * e; Pw[i] = (f32x2){(float)(mag * cos(ang)), (float)(mag * sin(ang))}; }
            __syncthreads();
            for (int i = tid; i < 2048; i += NTHREADS) { const int dir = i >> 10, p = (i >> 4) & 63, cp = i & 15; const int src = ((dir * NG + g) * NP + p) * GC + cp;
                const float br = a.in[I_BRE][src], bi = a.in[I_BIM][src]; const f32x2 f = Fm[dir * 64 + p]; Bf[i] = (f32x2){f.x * br - f.y * bi, f.x * bi + f.y * br}; }
            __syncthreads();
            const int k = tid >> 5, c = (tid >> 1) & 15, hf = tid & 1, tp = 16 * s + k, ts = tp - 63;
            if (tp < 127) {
                float acc[8];
#pragma unroll
                for (int j = 0; j < 8; ++j) acc[j] = 0.f;
                for (int dir = 0; dir < 2; ++dir) {
                    if (ts > 0 && dir == 1) continue; if (ts < 0 && dir == 0) continue;
                    for (int p = 0; p < 64; ++p) { const f32x2 cc = Cc[(dir * 16 + c) * 64 + p]; f32x2 w = cc; if (ts != 0) { const f32x2 pw = Pw[k * 64 + p]; w = (f32x2){cc.x * pw.x - cc.y * pw.y, cc.x * pw.y + cc.y * pw.x}; }
#pragma unroll
                        for (int j = 0; j < 8; ++j) { const f32x2 b = Bf[(dir * 64 + p) * 16 + 8 * hf + j]; acc[j] += w.x * b.x - w.y * b.y; } }
                }
                if (ts == 0) {
#pragma unroll
                    for (int j = 0; j < 8; ++j) if (8 * hf + j == c) acc[j] += a.in[I_DSK][g * GC + c]; }
                float* kt = (float*)(ws + WS_KT) + ((size_t)(g * 127 + tp) * 16 + c) * 16 + 8 * hf;
                *(f32x4*)kt = (f32x4){acc[0], acc[1], acc[2], acc[3]}; *(f32x4*)(kt + 4) = (f32x4){acc[4], acc[5], acc[6], acc[7]};
            }
            __syncthreads();
        }
    }
    {
        LAS float* scr = (LAS float*)(lds + wave * 16384);
        constexpr int I0 = 16 * 152, I1 = I0 + 8 * 16, I2 = I1 + 4 * 32, I3 = I2 + 8 * 32, I4 = I3 + 16 * 32, I5 = I4 + 32 * 16 * 64, I6 = I5 + 32 * 16 * 32;
        for (int it = gw; it < I6; it += NGW) {
            if (it < I0) p0_transpose_item(a.in[I_WIN], 1024, INW, (bf16*)(ws + WS_WIN), 1, a.in[I_NORM1], scr, it, lane);
            else if (it < I1) p0_transpose_item(a.in[I_WGLU], 512, 512, (bf16*)(ws + WS_WGLU), 0, nullptr, scr, it - I0, lane);
            else if (it < I2) p0_transpose_item(a.in[I_WA], 256, 1024, (bf16*)(ws + WS_WA), 0, nullptr, scr, it - I1, lane);
            else if (it < I3) p0_transpose_item(a.in[I_WS], 512, 1024, (bf16*)(ws + WS_WS), 0, nullptr, scr, it - I2, lane);
            else if (it < I4) p0_transpose_item(a.in[I_WO], 1024, 1024, (bf16*)(ws + WS_WO), 0, nullptr, scr, it - I3, lane);
            else if (it < I5) { const int r = it - I4, e = r >> 10; p0_transpose_item(a.in[I_WGU] + (size_t)e * 1024 * 2048, 1024, 2048, (bf16*)(ws + WS_WGU) + (size_t)e * 2048 * 1024, 2, a.in[I_NORM2], scr, r & 1023, lane); }
            else { const int r = it - I5, e = r >> 9; p0_transpose_item(a.in[I_WD] + (size_t)e * 1024 * 1024, 1024, 1024, (bf16*)(ws + WS_WD) + (size_t)e * 1024 * 1024, 0, nullptr, scr, r & 511, lane); }
        }
    }
    for (int m = gw; m < T; m += NGW) {
        const f32x4* xr = (const f32x4*)(a.in[I_X] + (size_t)m * DM) + lane; f32x4 v[4]; float s = 0.f;
#pragma unroll
        for (int j = 0; j < 4; ++j) { v[j] = xr[64 * j]; s += (v[j][0] * v[j][0] + v[j][1] * v[j][1]) + (v[j][2] * v[j][2] + v[j][3] * v[j][3]); }
        const float tot = wave_sum(s); if (lane == 0) ((float*)(ws + WS_RSTD1))[m] = rsqrtf(tot * (1.0f / DM) + NORM_EPS);
        u32x2* o8 = (u32x2*)((bf16*)(ws + WS_XB) + (size_t)m * DM) + lane;
#pragma unroll
        for (int j = 0; j < 4; ++j) { u32x2 w; w.x = pk2(v[j][0], v[j][1]); w.y = pk2(v[j][2], v[j][3]); o8[64 * j] = w; }
    }
    for (int idx = gt; idx < SEQ * 32; idx += NT) { const int pos = idx >> 5, i = idx & 31; const double ang = (double)pos * exp(-(double)i * (9.210340371976184 / 32.0));
        ((f32x2*)(ws + WS_ROPE))[idx] = (f32x2){(float)cos(ang), (float)sin(ang)}; }
    for (int idx = gt; idx < NG * 2 * NP * 65; idx += NT) { const int e = idx % 65, gp = idx / 65, p = gp & 63, dir = (gp >> 6) & 1, g = gp >> 7; double lr, li, dt; s5_mode(a, g, dir, p, lr, li, dt);
        const double mag = exp(lr * dt * e), ang = li * dt * e; ((f32x2*)(ws + WS_POW))[idx] = (f32x2){(float)(mag * cos(ang)), (float)(mag * sin(ang))}; }
    for (int idx = gt; idx < NG * 2 * NP; idx += NT) { const int p = idx & 63, dir = (idx >> 6) & 1, g = idx >> 7; double lr, li, dt; s5_mode(a, g, dir, p, lr, li, dt);
        const double mag = exp(lr * dt), ar = mag * cos(li * dt), ai = mag * sin(li * dt), nr = ar - 1.0, den = lr * lr + li * li; const float fr = (float)((nr * lr + ai * li) / den), fi = (float)((ai * lr - nr * li) / den);
        for (int cp = 0; cp < 16; ++cp) { const int src = ((dir * NG + g) * NP + p) * GC + cp; const float br = a.in[I_BRE][src], bi = a.in[I_BIM][src]; ((f32x2*)(ws + WS_BF))[idx * 16 + cp] = (f32x2){fr * br - fi * bi, fr * bi + fi * br}; } }
}
__device__ __forceinline__ void p1_expand(const Args& a, int gt, int NT) {
    unsigned char* ws = a.ws; const float* KT = (const float*)(ws + WS_KT); const f32x2* POW = (const f32x2*)(ws + WS_POW); const f32x2* BF = (const f32x2*)(ws + WS_BF);
    bf16* BT2 = (bf16*)(ws + WS_BT2); bf16* BT1 = (bf16*)(ws + WS_BT1);
    for (int idx = gt; idx < NG * 1024 * 160; idx += NT) {
        const int k8 = idx % 160, n = (idx / 160) & 1023, g = idx / 163840, tl = n >> 4, c = n & 15; u32x4 o;
        if (k8 < 128) { const int kp = k8 >> 1, c0 = 8 * (k8 & 1); const float* s = KT + ((size_t)(g * 127 + (tl - kp + 63)) * 16 + c) * 16 + c0; o = pack8(*(const f32x4*)s, *(const f32x4*)(s + 4)); }
        else { const int kk = (k8 - 128) * 8, seg = kk >> 6, p0 = kk & 63, dir = seg >> 1, e = dir == 0 ? tl + 1 : 64 - tl; float v[8];
#pragma unroll
            for (int j = 0; j < 8; ++j) { const int p = p0 + j, src = ((dir * NG + g) * GC + c) * NP + p; const float cr = a.in[I_CRE][src], ci = a.in[I_CIM][src]; const f32x2 pw = POW[(size_t)((g * 2 + dir) * 64 + p) * 65 + e];
                v[j] = (seg & 1) ? -(cr * pw.y + ci * pw.x) : (cr * pw.x - ci * pw.y); }
            o.x = pk2(v[0], v[1]); o.y = pk2(v[2], v[3]); o.z = pk2(v[4], v[5]); o.w = pk2(v[6], v[7]); }
        *(u32x4*)(BT2 + ((size_t)(g * 1024 + n) * KA2 + 8 * k8)) = o;
    }
    for (int idx = gt; idx < NG * 256 * 128; idx += NT) {
        const int k8 = idx & 127, n = (idx >> 7) & 255, g = idx >> 15, kl = k8 >> 1, c0 = 8 * (k8 & 1), seg = n >> 6, p = n & 63, dir = seg >> 1, e = dir == 0 ? 63 - kl : kl;
        const f32x2 pw = POW[(size_t)((g * 2 + dir) * 64 + p) * 65 + e]; float v[8];
#pragma unroll
        for (int j = 0; j < 8; ++j) { const f32x2 b = BF[(size_t)((g * 2 + dir) * 64 + p) * 16 + c0 + j]; v[j] = (seg & 1) ? (pw.x * b.y + pw.y * b.x) : (pw.x * b.x - pw.y * b.y); }
        u32x4 o; o.x = pk2(v[0], v[1]); o.y = pk2(v[2], v[3]); o.z = pk2(v[4], v[5]); o.w = pk2(v[6], v[7]);
        *(u32x4*)(BT1 + ((size_t)(g * 256 + n) * 1024 + 8 * k8)) = o;
    }
}
typedef short v4i16_t __attribute__((ext_vector_type(4)));
__device__ __forceinline__ void attn_unit(LAS unsigned char* lds, const bf16* Q, const bf16* Kb, const bf16* V, bf16* O, float* LSE, int hd, int qb, int tid) {
    const int lane = tid & 63, w = __builtin_amdgcn_readfirstlane(tid >> 6), q = lane & 31, h = lane >> 5;
    const int g = hd >> 2, sh = 2 * g, Ls = SEQ >> sh, prow0 = qb * 256, seq0 = prow0 & ~(Ls - 1);
    const bf16* Kg = Kb + (size_t)hd * T * 64; const bf16* Vg = V + (size_t)hd * T * 64; const bf16* Qg = Q + (size_t)hd * T * 64;
    constexpr int KP = 144;
    LAS unsigned char* Kl = lds; LAS unsigned char* Vl = lds + 384 * KP;
    for (int idx = tid; idx < 3072; idx += NTHREADS) { const int kr = idx >> 3, ch = idx & 7, prow = prow0 - 64 + kr; u32x4 kv = {0u, 0u, 0u, 0u}, vv = {0u, 0u, 0u, 0u};
        if (prow >= seq0 && prow < seq0 + Ls) { kv = *(const u32x4*)(Kg + (size_t)prow * 64 + ch * 8); vv = *(const u32x4*)(Vg + (size_t)prow * 64 + ch * 8); }
        *(LAS u32x4*)(Kl + kr * KP + ch * 16) = kv; *(LAS u32x4*)(Vl + kr * KP + ch * 16) = vv; }
    bf16x8 qf[4];
#pragma unroll
    for (int s = 0; s < 4; ++s) qf[s] = *(const bf16x8*)(Qg + (size_t)(prow0 + 32 * w + q) * 64 + 16 * s + 8 * h);
    __syncthreads();
    f32x16 sc[5];
#pragma unroll
    for (int kb = 0; kb < 5; ++kb) { f32x16 acc = {};
#pragma unroll
        for (int s = 0; s < 4; ++s) { const bf16x8 kf = *(const LAS bf16x8*)(Kl + (32 * w + 32 * kb + q) * KP + (16 * s + 8 * h) * 2); acc = __builtin_amdgcn_mfma_f32_32x32x16_bf16(kf, qf[s], acc, 0, 0, 0); }
        sc[kb] = acc; }
    const int qpos = prow0 + 32 * w + q - seq0; float m = -INFINITY;
#pragma unroll
    for (int kb = 0; kb < 5; ++kb)
#pragma unroll
        for (int r = 0; r < 16; ++r) { const int kpos = prow0 - 64 + 32 * w + 32 * kb + (r & 3) + 8 * (r >> 2) + 4 * h - seq0, d = qpos - kpos;
            const bool ok = (d <= 64) && (d >= -64) && (kpos >= 0) && (kpos < Ls); const float v = ok ? sc[kb][r] : -INFINITY; sc[kb][r] = v; m = fmaxf(m, v); }
    m = fmaxf(m, __shfl_xor(m, 32)); float l = 0.f;
#pragma unroll
    for (int kb = 0; kb < 5; ++kb)
#pragma unroll
        for (int r = 0; r < 16; ++r) { const float pv = exp2f(sc[kb][r] - m); sc[kb][r] = pv; l += pv; }
    l += __shfl_xor(l, 32);
    f32x16 o[2] = {f32x16{}, f32x16{}};
    const int qq = (lane & 15) >> 2, pp = lane & 3, blk = (lane >> 4) & 1;
#pragma unroll
    for (int kb = 0; kb < 5; ++kb)
#pragma unroll
        for (int s2 = 0; s2 < 2; ++s2) {
            u32x4 pw; pw.x = pk2(sc[kb][8 * s2 + 0], sc[kb][8 * s2 + 1]); pw.y = pk2(sc[kb][8 * s2 + 2], sc[kb][8 * s2 + 3]); pw.z = pk2(sc[kb][8 * s2 + 4], sc[kb][8 * s2 + 5]); pw.w = pk2(sc[kb][8 * s2 + 6], sc[kb][8 * s2 + 7]);
            const bf16x8 pf = __builtin_bit_cast(bf16x8, pw);
#pragma unroll
            for (int c = 0; c < 2; ++c) {
                const int row = 32 * w + 32 * kb + 16 * s2 + 4 * h + qq; LAS unsigned char* ad = Vl + row * KP + (32 * c + 16 * blk + 4 * pp) * 2;
                const v4i16_t v0 = __builtin_amdgcn_ds_read_tr16_b64_v4i16((LAS v4i16_t*)ad), v1 = __builtin_amdgcn_ds_read_tr16_b64_v4i16((LAS v4i16_t*)(ad + 8 * KP));
                const bf16x8 vf = {v0[0], v0[1], v0[2], v0[3], v1[0], v1[1], v1[2], v1[3]};
                o[c] = __builtin_amdgcn_mfma_f32_32x32x16_bf16(vf, pf, o[c], 0, 0, 0);
            } }
    const float inv = 1.0f / l, L2 = m + log2f(l);
    const int prow = prow0 + 32 * w + q, b = prow >> 14, pq = prow & 16383, rr = pq >> (14 - sh), ii = pq & (Ls - 1), token = (b << 14) + (ii << sh) + rr;
    bf16* orow = O + ((size_t)g * T + token) * 256 + (hd & 3) * 64;
#pragma unroll
    for (int c = 0; c < 2; ++c)
#pragma unroll
        for (int rb = 0; rb < 4; ++rb) { u32x2 wv; wv.x = pk2(o[c][4 * rb] * inv, o[c][4 * rb + 1] * inv); wv.y = pk2(o[c][4 * rb + 2] * inv, o[c][4 * rb + 3] * inv); *(u32x2*)(orow + 32 * c + 8 * rb + 4 * h) = wv; }
    if (h == 0) LSE[((size_t)g * T + token) * 4 + (hd & 3)] = L2;
    __syncthreads();
}
__device__ __forceinline__ void p3_scan_combine(const Args& a, int gt, int NT) {
    unsigned char* ws = a.ws;
    if (gt < 2 * NG * 128) {
        const int cn = gt & 127, g = (gt >> 7) & 31, b = gt >> 12, dir = cn >> 6, p = cn & 63;
        const f32x2 aL = ((const f32x2*)(ws + WS_POW))[(size_t)((g * 2 + dir) * 64 + p) * 65 + 64];
        const float* E = (const float*)(ws + WS_E) + (size_t)(g * NCH + b * CHB) * 256 + dir * 128 + p; bf16* U = (bf16*)(ws + WS_UA) + (size_t)(g * NCH + b * CHB) * KA2 + 1024 + dir * 128 + p;
        float sr = 0.f, si = 0.f;
        for (int jb = 0; jb < CHB; jb += 8) { float er[8], ei[8];
#pragma unroll
            for (int u = 0; u < 8; ++u) { const int j = dir == 0 ? jb + u : CHB - 1 - (jb + u); er[u] = E[(size_t)j * 256]; ei[u] = E[(size_t)j * 256 + 64]; }
#pragma unroll
            for (int u = 0; u < 8; ++u) { const int j = dir == 0 ? jb + u : CHB - 1 - (jb + u); U[(size_t)j * KA2] = (bf16)f2bf(sr); U[(size_t)j * KA2 + 64] = (bf16)f2bf(si);
                const float nr = aL.x * sr - aL.y * si + er[u], ni = aL.x * si + aL.y * sr + ei[u]; sr = nr; si = ni; } }
    }
    const bf16* O = (const bf16*)(ws + WS_O); const float* LSE = (const float*)(ws + WS_LSE); bf16* AO = (bf16*)(ws + WS_AO);
    for (int idx = gt; idx < T * 32; idx += NT) { const int token = idx >> 5, j = (idx >> 3) & 3, ch = idx & 7;
        const float l0 = LSE[(size_t)token * 4 + j], l1 = LSE[((size_t)T + token) * 4 + j], l2 = LSE[((size_t)2 * T + token) * 4 + j], mx = fmaxf(l0, fmaxf(l1, l2));
        float w0 = exp2f(l0 - mx), w1 = exp2f(l1 - mx), w2 = exp2f(l2 - mx); const float ws_ = 1.0f / (w0 + w1 + w2); w0 *= ws_; w1 *= ws_; w2 *= ws_;
        const size_t off = (size_t)token * 256 + j * 64 + ch * 8; f32x4 a0, b0, a1, b1, a2, b2;
        unpack8(*(const u32x4*)(O + off), a0, b0); unpack8(*(const u32x4*)(O + (size_t)T * 256 + off), a1, b1); unpack8(*(const u32x4*)(O + (size_t)2 * T * 256 + off), a2, b2);
        *(u32x4*)(AO + off) = pack8(a0 * w0 + a1 * w1 + a2 * w2, b0 * w0 + b1 * w1 + b2 * w2); }
}
__device__ __forceinline__ void p8_router(const Args& a, LAS unsigned char* lds, int tid, int blk) {
    unsigned char* ws = a.ws; const int lane = tid & 63, w = __builtin_amdgcn_readfirstlane(tid >> 6), i = lane & 31, h = lane >> 5;
    LAS float* lg = (LAS float*)lds;
    LAS float* ssq = (LAS float*)(lds + 8 * 32 * 33 * 4);
    LAS int* hist = (LAS int*)(lds + 8 * 32 * 33 * 4 + 8 * 64 * 4);
    if (tid < 32) hist[tid] = 0;
    const int task = w & 3, kq = 2 * (w >> 2) + h, tok = blk * 128 + 32 * task + i;
    const float* xr = a.out + (size_t)tok * DM + 256 * kq; const float* g2 = a.in[I_NORM2] + 256 * kq; const float* wr = a.in[I_WR] + (size_t)(256 * kq) * NE + i;
    f32x16 acc = {}; float ss = 0.f;
#pragma unroll 2
    for (int kk = 0; kk < 256; kk += 4) { const f32x4 xv = *(const f32x4*)(xr + kk), gv = *(const f32x4*)(g2 + kk);
#pragma unroll
        for (int u = 0; u < 4; ++u) { acc = __builtin_amdgcn_mfma_f32_32x32x2f32(xv[u] * gv[u], wr[(size_t)(kk + u) * NE], acc, 0, 0, 0); ss += xv[u] * xv[u]; } }
#pragma unroll
    for (int r = 0; r < 16; ++r) lg[(w * 32 + (r & 3) + 8 * (r >> 2) + 4 * h) * 33 + i] = acc[r];
    ssq[w * 64 + lane] = ss;
    __syncthreads();
    if (w < 4 && lane < 32) {
        const float st = (ssq[w * 64 + i] + ssq[w * 64 + 32 + i]) + (ssq[(w + 4) * 64 + i] + ssq[(w + 4) * 64 + 32 + i]); const float rstd = rsqrtf(st * (1.0f / DM) + NORM_EPS);
        float v[32];
#pragma unroll
        for (int e = 0; e < 32; ++e) v[e] = (lg[(w * 32 + i) * 33 + e] + lg[((w + 4) * 32 + i) * 33 + e]) * rstd + a.in[I_BR][e];
        float tv[4]; int ti[4];
#pragma unroll
        for (int k = 0; k < 4; ++k) { float best = -INFINITY; int bi = 0;
#pragma unroll
            for (int e = 0; e < 32; ++e) if (v[e] > best) { best = v[e]; bi = e; }
#pragma unroll
            for (int e = 0; e < 32; ++e) if (e == bi) v[e] = -INFINITY;
            tv[k] = best; ti[k] = bi; }
        const float e1 = __expf(tv[1] - tv[0]), e2 = __expf(tv[2] - tv[0]), e3 = __expf(tv[3] - tv[0]), inv = 1.0f / (1.0f + e1 + e2 + e3);
        const int t2 = blk * 128 + 32 * w + i;
        ((float*)(ws + RT_RSTD2))[t2] = rstd;
        *(f32x4*)((float*)(ws + RT_TOPW) + (size_t)t2 * 4) = (f32x4){inv, e1 * inv, e2 * inv, e3 * inv};
        int* tip = (int*)(ws + RT_TOPI) + (size_t)t2 * 4; tip[0] = ti[0]; tip[1] = ti[1]; tip[2] = ti[2]; tip[3] = ti[3];
#pragma unroll
        for (int k = 0; k < 4; ++k) __hip_atomic_fetch_add(&hist[ti[k]], 1, __ATOMIC_RELAXED, __HIP_MEMORY_SCOPE_WORKGROUP);
    }
    __syncthreads();
    if (tid < 32) ((int*)(ws + RT_CNT))[blk * 32 + tid] = hist[tid];
}
__device__ __forceinline__ void p9_rowlists(const Args& a, LAS unsigned char* lds, int tid, int blk) {
    unsigned char* ws = a.ws; const int lane = tid & 63, w = __builtin_amdgcn_readfirstlane(tid >> 6);
    LAS int* part_all = (LAS int*)lds;
    LAS int* part_pre = part_all + 512;
    LAS int* tot = part_pre + 512;
    LAS int* pre = tot + 32;
    LAS int* base = pre + 32;
    LAS int* wcnt = base + 64;
    const int* CNT = (const int*)(ws + RT_CNT);
    { const int e = tid & 31, part = tid >> 5; int sa = 0, sp = 0;
      for (int bb = 16 * part; bb < 16 * part + 16; ++bb) { const int v = CNT[bb * 32 + e]; sa += v; if (bb < blk) sp += v; }
      part_all[part * 32 + e] = sa; part_pre[part * 32 + e] = sp; }
    __syncthreads();
    if (tid < 32) { int sa = 0, sp = 0; for (int part = 0; part < 16; ++part) { sa += part_all[part * 32 + tid]; sp += part_pre[part * 32 + tid]; } tot[tid] = sa; pre[tid] = sp; }
    __syncthreads();
    if (tid == 0) { int acc = 0; for (int e = 0; e < 32; ++e) { base[e] = acc; acc += (tot[e] + 255) & ~255; } base[32] = acc; }
    const int tok = blk * 128 + (tid >> 2), k = tid & 3; const int e = ((const int*)(ws + RT_TOPI))[(size_t)tok * 4 + k]; const float wv = ((const float*)(ws + RT_TOPW))[(size_t)tok * 4 + k];
    int rank = 0;
#pragma unroll 4
    for (int ee = 0; ee < 32; ++ee) { const unsigned long long mk = __ballot(e == ee); if (e == ee) rank = __popcll(mk & ((1ull << lane) - 1ull)); if (lane == 0) wcnt[w * 32 + ee] = __popcll(mk); }
    __syncthreads();
    int off = 0; for (int ww = 0; ww < w; ++ww) off += wcnt[ww * 32 + e];
    const int dest = base[e] + pre[e] + off + rank;
    ((int*)(ws + RT_ROWTOK))[dest] = tok; ((int*)(ws + RT_ROWDST))[dest] = tok * 4 + k; ((float*)(ws + RT_ROWW))[dest] = wv;
    if (blk == 0) {
        for (int ee = 0; ee < 32; ++ee) { const int s0 = base[ee] + tot[ee], s1 = base[ee + 1]; for (int r = s0 + tid; r < s1; r += NTHREADS) { ((int*)(ws + RT_ROWTOK))[r] = 0; ((int*)(ws + RT_ROWDST))[r] = -1; ((float*)(ws + RT_ROWW))[r] = 0.f; } }
        if (tid <= 32) ((int*)(ws + RT_META))[tid] = base[tid] >> 8;
    }
    __syncthreads();
}
__device__ __forceinline__ void p12_final(const Args& a, int gt, int NT) {
    const bf16* Y4 = (const bf16*)(a.ws + WS_Y4);
    for (int idx = gt; idx < T * 128; idx += NT) { const int token = idx >> 7, c8 = (idx & 127) * 8; float* o = a.out + (size_t)token * DM + c8; f32x4 va = *(const f32x4*)o, vb = *(const f32x4*)(o + 4);
#pragma unroll
        for (int k = 0; k < 4; ++k) { f32x4 ya, yb; unpack8(*(const u32x4*)(Y4 + ((size_t)token * 4 + k) * DM + c8), ya, yb); va += ya; vb += yb; }
        *(f32x4*)o = va; *(f32x4*)(o + 4) = vb; }
}

#define XB_TMO      128
#define XB_XCNT(j)  (256  + 64 * (j))
#define XB_XSUB(j)  (1280 + 64 * (j))
#define XB_XGEN(j)  (2304 + 64 * (j))
#define XB_TOP      3328
#define XB_TOPGEN   3392
#define XCD_BAR_WORDS 3456
#define XB_SPIN_CAP (1u << 18)
__device__ __forceinline__ unsigned xb_ld(unsigned* p)              { return __hip_atomic_load(p, __ATOMIC_RELAXED, __HIP_MEMORY_SCOPE_AGENT); }
__device__ __forceinline__ unsigned xb_add(unsigned* p, unsigned v) { return __hip_atomic_fetch_add(p, v, __ATOMIC_RELAXED, __HIP_MEMORY_SCOPE_AGENT); }
__device__ __forceinline__ unsigned xb_xcc_id() { return (unsigned)__builtin_amdgcn_s_getreg((3 << 11) | 20) & 0xFu; }
#define XB_SPIN(cond, bar) do { unsigned _sp = 0; while (cond) { __builtin_amdgcn_s_sleep(1); \
    if ((++_sp & 255u) == 0u) { if (xb_ld(&(bar)[XB_TMO])) break; if (_sp > XB_SPIN_CAP) { atomicAdd(&(bar)[XB_TMO], 1u); break; } } } } while (0)
struct XcdBarrier { unsigned* bar; unsigned x; volatile LAS unsigned* st; };
__device__ __forceinline__ XcdBarrier xcd_barrier_post(unsigned* bar, volatile LAS unsigned* st) {
    XcdBarrier b; b.bar = bar; b.x = xb_xcc_id(); b.st = st;
    if (threadIdx.x == 0) (void)xb_add(&bar[XB_XCNT(b.x)], 1u);
    return b;
}
__device__ __forceinline__ void xcd_barrier_complete(unsigned* bar, unsigned x, unsigned& nloc, unsigned& nx) {
    const unsigned G = gridDim.x * gridDim.y * gridDim.z;
    unsigned sum, cnt, mine, sp = 0u;
    for (;;) {
        sum = 0u; cnt = 0u; mine = 0u;
#pragma unroll
        for (unsigned j = 0; j < 16; ++j) { const unsigned c = xb_ld(&bar[XB_XCNT(j)]); sum += c; cnt += (c > 0u) ? 1u : 0u; mine = (j == x) ? c : mine; }
        if (sum == G) break;
        __builtin_amdgcn_s_sleep(1);
        if ((++sp & 255u) == 0u) { if (xb_ld(&bar[XB_TMO])) break; if (sp > XB_SPIN_CAP) { atomicAdd(&bar[XB_TMO], 1u); break; } }
    }
    nloc = mine > 0u ? mine : 1u; nx = cnt > 0u ? cnt : 1u;
}
__device__ __forceinline__ void xcd_barrier(const XcdBarrier& b) {
    asm volatile("s_waitcnt vmcnt(0)" ::: "memory");
    __syncthreads();
    if (threadIdx.x == 0) {
        unsigned* bar = b.bar;
        __builtin_amdgcn_s_waitcnt(0);
        unsigned nloc = b.st[0], nx = b.st[1];
        if (nloc == 0u) { xcd_barrier_complete(bar, b.x, nloc, nx); b.st[0] = nloc; b.st[1] = nx; }
        const unsigned old = xb_add(&bar[XB_XSUB(b.x)], 1u);
        const unsigned gen = old / nloc;
        if (old + 1u == (gen + 1u) * nloc) {
            __builtin_amdgcn_fence(__ATOMIC_RELEASE, "agent");
            asm volatile("s_waitcnt vmcnt(0)" ::: "memory");
            const unsigned og = xb_add(&bar[XB_TOP], 1u);
            const unsigned tg = og / nx;
            if (og + 1u == (tg + 1u) * nx) xb_add(&bar[XB_TOPGEN], 1u);
            else XB_SPIN(xb_ld(&bar[XB_TOPGEN]) == tg, bar);
            __builtin_amdgcn_fence(__ATOMIC_ACQUIRE, "agent");
            xb_add(&bar[XB_XGEN(b.x)], 1u);
            asm volatile("s_waitcnt vmcnt(0)" ::: "memory");
        } else {
            XB_SPIN(xb_ld(&bar[XB_XGEN(b.x)]) == gen, bar);
            __builtin_amdgcn_fence(__ATOMIC_ACQUIRE, "agent");
            asm volatile("s_waitcnt vmcnt(0)" ::: "memory");
        }
    }
    __syncthreads();
}

constexpr int N_PHASES = 13;
__global__ void __launch_bounds__(NTHREADS, 2) mega_fwd(Args args) {
    extern __shared__ __attribute__((aligned(16))) unsigned char lds_[];
    LAS unsigned char* lds = (LAS unsigned char*)lds_;
    volatile LAS unsigned* MISC = (volatile LAS unsigned*)(lds + MISC_OFF);
    const int tid = threadIdx.x, lane = tid & 63, wave = __builtin_amdgcn_readfirstlane(tid >> 6);
    const int G = gridDim.x, bx = blockIdx.x, vcu = (G % 8 == 0) ? (bx % 8) * (G / 8) + bx / 8 : bx;
    unsigned char* ws = args.ws; unsigned* ctl = (unsigned*)(ws + WS_CTL);
    for (int u = tid; u < (LDS_BYTES - LDSX_OFF) / 4; u += NTHREADS) ((LAS unsigned*)(lds + LDSX_OFF))[u] = 0u;
    __syncthreads();
    XcdBarrier bar; bar.bar = ctl + CW_BAR; bar.x = 0; bar.st = nullptr;
    if (MK_N_LAUNCHES == 1) bar = xcd_barrier_post(ctl + CW_BAR, MISC + 8);
    const int lo = args.ph_lo, hi = args.ph_hi;
#define IN(k) (lo <= (k) && (k) < hi)
#define SEAM(k) do { if (IN(k) && IN((k) + 1)) xcd_barrier(bar); } while (0)
    const int gt = vcu * NTHREADS + tid, NT = G * NTHREADS;
    const LAS int* tpre = (const LAS int*)(lds + TPRE_OFF);

    if (IN(0)) { p0_prologue(args, lds, tid, lane, wave, vcu, G); }
    SEAM(0);
    if (IN(1)) {
        p1_expand(args, gt, NT);
        PolG1 p; p.K = 1024; p.G = G; p.c = bx; p.XB = (const bf16*)(ws + WS_XB); p.WT = (const bf16*)(ws + WS_WIN); p.rstd1 = (const float*)(ws + WS_RSTD1);
        p.qn = args.in[I_QN]; p.kn = args.in[I_KN]; p.rope = (const float*)(ws + WS_ROPE);
        p.Q = (bf16*)(ws + WS_Q); p.Kb = (bf16*)(ws + WS_K); p.V = (bf16*)(ws + WS_V); p.UA = (bf16*)(ws + WS_UA); p.GT = (bf16*)(ws + WS_GATES);
        pg8::gemm_phase(lds, p);
    }
    SEAM(1);
    if (IN(2)) {
        { PolS5a p; p.K = 1024; p.G = G; p.c = bx; p.UA = (const bf16*)(ws + WS_UA); p.BT1 = (const bf16*)(ws + WS_BT1); p.E = (float*)(ws + WS_E); pg8::gemm_phase(lds, p); }
        __syncthreads();
        for (int L = vcu; L < NH * 128; L += G) attn_unit(lds, (const bf16*)(ws + WS_Q), (const bf16*)(ws + WS_K), (const bf16*)(ws + WS_V), (bf16*)(ws + WS_O), (float*)(ws + WS_LSE), L >> 7, L & 127, tid);
    }
    SEAM(2);
    if (IN(3)) { p3_scan_combine(args, gt, NT); }
    SEAM(3);
    if (IN(4)) { PolS5b p; p.K = KA2; p.G = G; p.vcu = vcu; p.UA = (const bf16*)(ws + WS_UA); p.BT2 = (const bf16*)(ws + WS_BT2); p.Z = (bf16*)(ws + WS_Z); pg8::gemm_phase(lds, p); }
    SEAM(4);
    if (IN(5)) {
        { PolDense<0> p; p.K = 512; p.G = G; p.c = bx; p.nN = 2; p.A = DenseA{(const bf16*)(ws + WS_Z), 512}; p.Bt = (const bf16*)(ws + WS_WGLU);
          p.in0 = (const bf16*)(ws + WS_Z); p.in1 = nullptr; p.fin = nullptr; p.bias = args.in[I_BGLU]; p.o16 = (bf16*)(ws + WS_GLU); p.o32 = nullptr; pg8::gemm_phase(lds, p); }
        { PolDense<1> p; p.K = 256; p.G = G; p.c = bx; p.nN = 4; p.A = DenseA{(const bf16*)(ws + WS_AO), 256}; p.Bt = (const bf16*)(ws + WS_WA);
          p.in0 = (const bf16*)(ws + WS_GATES); p.in1 = nullptr; p.fin = nullptr; p.bias = nullptr; p.o16 = (bf16*)(ws + WS_T1); p.o32 = nullptr; pg8::gemm_phase(lds, p); }
    }
    SEAM(5);
    if (IN(6)) { PolDense<2> p; p.K = 512; p.G = G; p.c = bx; p.nN = 4; p.A = DenseA{(const bf16*)(ws + WS_GLU), 512}; p.Bt = (const bf16*)(ws + WS_WS);
        p.in0 = (const bf16*)(ws + WS_GATES); p.in1 = (const bf16*)(ws + WS_T1); p.fin = nullptr; p.bias = nullptr; p.o16 = (bf16*)(ws + WS_MIXED); p.o32 = nullptr; pg8::gemm_phase(lds, p); }
    SEAM(6);
    if (IN(7)) { PolDense<3> p; p.K = 1024; p.G = G; p.c = bx; p.nN = 4; p.A = DenseA{(const bf16*)(ws + WS_MIXED), 1024}; p.Bt = (const bf16*)(ws + WS_WO);
        p.in0 = nullptr; p.in1 = nullptr; p.fin = args.in[I_X]; p.bias = nullptr; p.o16 = (bf16*)(ws + WS_X1B); p.o32 = args.out; pg8::gemm_phase(lds, p); }
    SEAM(7);
    if (IN(8)) { p8_router(args, lds, tid, bx); }
    SEAM(8);
    if (IN(9)) { p9_rowlists(args, lds, tid, bx); }
    SEAM(9);
    if (IN(10)) {
        if (tid <= 32) ((LAS int*)(lds + TPRE_OFF))[tid] = ((const int*)(ws + RT_META))[tid];
        __syncthreads();
        PolMoeGU p; p.K = 1024; p.G = G; p.vcu = vcu; p.tp = tpre; p.X1B = (const bf16*)(ws + WS_X1B); p.WGU = (const bf16*)(ws + WS_WGU); p.rowtok = (const int*)(ws + RT_ROWTOK);
        p.rstd2 = (const float*)(ws + RT_RSTD2); p.bgu = args.in[I_BGU]; p.ACT = (bf16*)(ws + WS_ACT); pg8::gemm_phase(lds, p);
    }
    SEAM(10);
    if (IN(11)) {
        if (tid <= 32) ((LAS int*)(lds + TPRE_OFF))[tid] = ((const int*)(ws + RT_META))[tid];
        __syncthreads();
        PolMoeDN p; p.K = 1024; p.G = G; p.vcu = vcu; p.tp = tpre; p.ACT = (const bf16*)(ws + WS_ACT); p.WD = (const bf16*)(ws + WS_WD); p.rowdst = (const int*)(ws + RT_ROWDST);
        p.roww = (const float*)(ws + RT_ROWW); p.bd = args.in[I_BD]; p.Y4 = (bf16*)(ws + WS_Y4); pg8::gemm_phase(lds, p);
    }
    SEAM(11);
    if (IN(12)) { p12_final(args, gt, NT); }
#undef IN
#undef SEAM
}

extern "C" void kernel_launch(void* const* d_in, const int* in_sizes, int n_in, void* d_out, int out_size, void* d_ws, size_t ws_size, hipStream_t stream) {
    static int grid = 0;
    if (grid == 0) {
        if (n_in != 25 || in_sizes[0] != T * DM || out_size != T * DM || ws_size < WS_END) {
            fprintf(stderr, "kernel_launch: unexpected shapes/workspace: n_in %d in0 %d out %d ws %zu (need %zu); nothing launched\n", n_in, n_in > 0 ? in_sizes[0] : -1, out_size, ws_size, (size_t)WS_END); grid = -1; return; }
        int dev = 0, cus = 0;
        if (hipGetDevice(&dev) != hipSuccess || hipDeviceGetAttribute(&cus, hipDeviceAttributeMultiprocessorCount, dev) != hipSuccess) { fprintf(stderr, "kernel_launch: device query failed\n"); grid = -1; return; }
        if (hipFuncSetAttribute((const void*)mega_fwd, hipFuncAttributeMaxDynamicSharedMemorySize, LDS_BYTES) != hipSuccess) { fprintf(stderr, "kernel_launch: hipFuncSetAttribute failed\n"); grid = -1; return; }
        int per_cu = 0;
        if (hipOccupancyMaxActiveBlocksPerMultiprocessor(&per_cu, (const void*)mega_fwd, NTHREADS, LDS_BYTES) != hipSuccess || per_cu < 1) fprintf(stderr, "kernel_launch: note: occupancy query reports %d blocks per CU\n", per_cu);
        (void)hipGetLastError();
        grid = cus;
        if (grid != 256) fprintf(stderr, "kernel_launch: built for a 256-CU device, got %d CUs\n", grid);
    }
    if (grid < 0) return;
    if (hipMemsetAsync((char*)d_ws + WS_CTL, 0, CTL_ZERO_BYTES, stream) != hipSuccess) { fprintf(stderr, "kernel_launch: memset failed\n"); return; }
    Args a{};
    for (int i = 0; i < 25; ++i) a.in[i] = (const float*)d_in[i];
    a.out = (float*)d_out; a.ws = (unsigned char*)d_ws;
    if (MK_N_LAUNCHES == 1) {
        a.ph_lo = 0; a.ph_hi = N_PHASES;
        hipLaunchKernelGGL(mega_fwd, dim3(grid), dim3(NTHREADS), LDS_BYTES, stream, a);
    } else {
        for (int ph = 0; ph < N_PHASES; ++ph) { a.ph_lo = ph; a.ph_hi = ph + 1; hipLaunchKernelGGL(mega_fwd, dim3(grid), dim3(NTHREADS), LDS_BYTES, stream, a); }
    }
    const hipError_t le = hipPeekAtLastError();
    if (le != hipSuccess) fprintf(stderr, "kernel_launch: launch failed: %s\n", hipGetErrorName(le));
}
```

```cpp
#include <hip/hip_runtime.h>
#include <cstdio>
#include <cstdint>

#ifndef MK_N_LAUNCHES
#define MK_N_LAUNCHES 1
#endif

#define GAS __attribute__((address_space(1)))
#define LAS __attribute__((address_space(3)))
typedef unsigned short bf16;
typedef short bf16x8 __attribute__((ext_vector_type(8)));
typedef short s16x4 __attribute__((ext_vector_type(4)));
typedef float f32x2 __attribute__((ext_vector_type(2)));
typedef float f32x4 __attribute__((ext_vector_type(4)));
typedef float f32x16 __attribute__((ext_vector_type(16)));
typedef unsigned u32x2 __attribute__((ext_vector_type(2)));
typedef unsigned u32x4 __attribute__((ext_vector_type(4)));
typedef __bf16 bf16x2_t __attribute__((ext_vector_type(2)));

constexpr int T = 32768, DM = 1024, SEQ = 16384, NH = 12, HD = 64, INW = 4864;
constexpr int SSMW = 512, NG = 32, GC = 16, NP = 64;
constexpr int CL = 64, NCH = T / CL  , CHB = SEQ / CL  , KA2 = 1280;
constexpr int NE = 32, TOPK = 4, RMAX = T * TOPK + NE * 256;
constexpr float NORM_EPS = 1e-6f;
constexpr float QSCALE = 0.125f * 1.4426950408889634f;
constexpr int NWAVES = 8, NTHREADS = 512;

constexpr size_t MiB = 1u << 20;
constexpr size_t WS_CTL = 0, CTL_ZERO_BYTES = 1 * MiB;
constexpr size_t WS_WGU = 1 * MiB;
constexpr size_t WS_WD = WS_WGU + 128 * MiB;
constexpr size_t WS_X1B = WS_WD + 64 * MiB;
constexpr size_t WS_ROUTE = WS_X1B + 64 * MiB;
constexpr size_t RT_RSTD2 = WS_ROUTE;
constexpr size_t RT_TOPI = RT_RSTD2 + 128 * 1024;
constexpr size_t RT_TOPW = RT_TOPI + 512 * 1024;
constexpr size_t RT_CNT = RT_TOPW + 512 * 1024;
constexpr size_t RT_META = RT_CNT + 32 * 1024;
constexpr size_t RT_ROWTOK = RT_META + 4096;
constexpr size_t RT_ROWDST = RT_ROWTOK + 576 * 1024;
constexpr size_t RT_ROWW = RT_ROWDST + 576 * 1024;
static_assert((size_t)RMAX * 4 <= 576 * 1024 && RT_ROWW + 576 * 1024 <= WS_ROUTE + 4 * MiB, "route map");
constexpr size_t WS_EARLY = WS_ROUTE + 4 * MiB;
constexpr size_t WS_WIN = WS_EARLY;
constexpr size_t WS_ROPE = WS_WIN + 10 * MiB;
constexpr size_t WS_POW = WS_ROPE + 4 * MiB;
constexpr size_t WS_AO = WS_WIN;
constexpr size_t WS_KT = WS_POW + 3 * MiB;
constexpr size_t WS_BF = WS_KT + 5 * MiB;
constexpr size_t WS_WSM = WS_BF + 1 * MiB;
constexpr size_t WS_WGLU = WS_WSM, WS_WA = WS_WSM + MiB / 2, WS_WS = WS_WSM + 1 * MiB, WS_WO = WS_WSM + 2 * MiB;
constexpr size_t WS_BT1 = WS_WSM + 4 * MiB;
constexpr size_t WS_E = WS_BT1 + 16 * MiB;
constexpr size_t WS_Z = WS_BT1;
constexpr size_t WS_BT2 = WS_E + 16 * MiB;
constexpr size_t WS_XB = WS_BT2 + 80 * MiB;
constexpr size_t WS_MIXED = WS_XB;
constexpr size_t WS_RSTD1 = WS_XB + 64 * MiB;
constexpr size_t WS_Q = WS_RSTD1 + 1 * MiB;
constexpr size_t WS_K = WS_Q + 48 * MiB;
constexpr size_t WS_V = WS_K + 48 * MiB;
constexpr size_t WS_T1 = WS_Q;
constexpr size_t WS_GLU = WS_V;
constexpr size_t WS_UA = WS_V + 48 * MiB;
constexpr size_t WS_GATES = WS_UA + 40 * MiB;
constexpr size_t WS_O = WS_GATES + 128 * MiB;
constexpr size_t WS_LSE = WS_O + 48 * MiB;
constexpr size_t WS_EARLY_END = WS_LSE + 2 * MiB;
constexpr size_t WS_ACT = WS_EARLY;
constexpr size_t WS_Y4 = WS_ACT + 272 * MiB;
constexpr size_t WS_END = (WS_EARLY_END > WS_Y4 + 256 * MiB) ? WS_EARLY_END : (WS_Y4 + 256 * MiB);
static_assert((size_t)RMAX * 2048 <= 272 * MiB, "ACT size");
static_assert(WS_END <= 1024 * MiB, "d_ws map must fit 1 GiB");

constexpr int CW_TMO = 0, CW_BAR = 4096;

constexpr int RING_BYTES = 131072, LDSX_OFF = RING_BYTES, MISC_OFF = LDSX_OFF + 320, TPRE_OFF = LDSX_OFF + 1024, LDS_BYTES = 147456;

#define RLX_AGENT __ATOMIC_RELAXED, __HIP_MEMORY_SCOPE_AGENT
#define LDS_WAIT() asm volatile("s_waitcnt lgkmcnt(0)" ::: "memory")
#define VM_WAIT() asm volatile("s_waitcnt vmcnt(0)" ::: "memory")
__device__ __forceinline__ unsigned f2bf(float f) { unsigned u = __builtin_bit_cast(unsigned, f); return (u + 0x7fffu + ((u >> 16) & 1u)) >> 16; }
__device__ __forceinline__ unsigned pk2(float lo, float hi) { f32x2 v = {lo, hi}; bf16x2_t b = __builtin_convertvector(v, bf16x2_t); return __builtin_bit_cast(unsigned, b); }
__device__ __forceinline__ float bflo(unsigned w) { return __builtin_bit_cast(float, w << 16); }
__device__ __forceinline__ float bfhi(unsigned w) { return __builtin_bit_cast(float, w & 0xffff0000u); }
__device__ __forceinline__ float bf2f(bf16 b) { return __builtin_bit_cast(float, (unsigned)b << 16); }
__device__ __forceinline__ float sigmoidf_(float x) { return 1.0f / (1.0f + __expf(-x)); }
__device__ __forceinline__ float gelu_tanh(float x) { const float u = 0.7978845608028654f * (x + 0.044715f * x * x * x); return x * sigmoidf_(2.0f * u); }
__device__ __forceinline__ float wave_sum(float v) {
#pragma unroll
    for (int o = 1; o < 64; o <<= 1) v += __shfl_xor(v, o);
    return v;
}

namespace pg8 {
constexpr int BM = 256, BK = 64, HALF = 128, HTB = HALF * BK * 2, STAGE_BYTES = 8 * HTB;
__host__ __device__ __forceinline__ int lds_byte(int r, int c) { const int st = (r >> 4) * 2 + (c >> 5), rr = r & 15, cc = c & 31, ob = rr * 64 + cc * 2; return st * 1024 + (ob ^ (((ob >> 9) & 1) << 5)); }
__host__ __device__ __forceinline__ void stage_rc(int b, int& R, int& C) { const int st = b / 1024, sb = b % 1024, swz = sb ^ (((sb >> 9) & 1) << 5); R = (st >> 1) * 16 + swz / 64; C = (st & 1) * 32 + (swz % 64) / 2; }
__host__ __device__ __forceinline__ int perm32(int rho) { const int n = rho >> 4, i = rho & 15; return 8 * (i >> 2) + 4 * n + (i & 3); }

struct Unit { int pm, pn, e, row0; };

__device__ __forceinline__ bool static_order(int nM, int nN, int G, int c, int i, int& pm, int& pn) {
    const int nwg = nM * nN; const long L = (long)i * G + c; if (L >= nwg) return false;
    int wgid = (int)L; { const int q = nwg / 8, r = nwg % 8, xcd = wgid % 8, off = wgid / 8; wgid = (xcd < r ? xcd * (q + 1) : r * (q + 1) + (xcd - r) * q) + off; }
    const int nig = 8 * nN, gid = wgid / nig, fm = gid * 8, gsz = (nM - fm) < 8 ? (nM - fm) : 8;
    pm = fm + ((wgid % nig) % gsz); pn = (wgid % nig) / gsz; return true;
}

template <class P>
__device__ __forceinline__ void gemm_phase(LAS unsigned char* lds, const P& p) {
    const int tid = threadIdx.x, wid = __builtin_amdgcn_readfirstlane(tid >> 6), lane = tid & 63, wr = wid >> 2, wc = wid & 3, fr = lane & 15, fq = lane >> 4;
    const int K = p.K, nt = K / BK;
    int R0, C0, R1, C1; stage_rc(tid * 16, R0, C0); stage_rc(tid * 16 + 8192, R1, C1);
    unsigned voffB[2], vA0[2], vA1[2];
    { const int Rb0 = P::PERM ? ((R0 & ~31) + perm32(R0 & 31)) : R0, Rb1 = P::PERM ? ((R1 & ~31) + perm32(R1 & 31)) : R1;
      voffB[0] = (unsigned)(Rb0 * K + C0) * 2u; voffB[1] = (unsigned)(Rb1 * K + C1) * 2u; }
    const size_t kstep = (size_t)(BK * 2);
    const size_t hstepB = (size_t)HALF * K * 2;
    const unsigned ldsw = (unsigned)wid * 1024u;
    const int aoff = lds_byte(wr * 64 + fr, fq * 8), boff = lds_byte(wc * 32 + fr, fq * 8);
#define PG8_SA(b, h) (((b) * 2 + (h)) * HTB)
#define PG8_SB(b, h) ((4 + (b) * 2 + (h)) * HTB)
#define PG8_STAGE(bufoff, gbase, voff) do { _Pragma("unroll") for (int _i = 0; _i < 2; ++_i) \
        __builtin_amdgcn_global_load_lds((const unsigned*)((const char*)(gbase) + (voff)[_i]), (LAS unsigned*)(lds + (bufoff) + ldsw + _i * 8192), 16, 0, 0); } while (0)
#define PG8_LDA(dst, b, h) do { _Pragma("unroll") for (int m = 0; m < 4; ++m) _Pragma("unroll") for (int k = 0; k < 2; ++k) dst[m][k] = *(const LAS bf16x8*)(lds + PG8_SA(b, h) + aoff + m * 2048 + k * 1024); } while (0)
#define PG8_LDB(dst, b, h) do { _Pragma("unroll") for (int n = 0; n < 2; ++n) _Pragma("unroll") for (int k = 0; k < 2; ++k) dst[n][k] = *(const LAS bf16x8*)(lds + PG8_SB(b, h) + boff + n * 2048 + k * 1024); } while (0)
#define PG8_MMA(ai, bj, At, Bt) do { __builtin_amdgcn_s_setprio(1); _Pragma("unroll") for (int m = 0; m < 4; ++m) _Pragma("unroll") for (int n = 0; n < 2; ++n) _Pragma("unroll") for (int k = 0; k < 2; ++k) \
        acc[ai][bj][m][n] = __builtin_amdgcn_mfma_f32_16x16x32_bf16(Bt[n][k], At[m][k], acc[ai][bj][m][n], 0, 0, 0); __builtin_amdgcn_s_setprio(0); } while (0)
#define PG8_WAIT_V(n) asm volatile("s_waitcnt vmcnt(" #n ")" ::: "memory")
#define PG8_WAIT_L(n) asm volatile("s_waitcnt lgkmcnt(" #n ")" ::: "memory")
#define PG8_BAR __builtin_amdgcn_s_barrier()
#define PG8_SCHED __builtin_amdgcn_sched_barrier(0)
    Unit cur, nxt; int ui = 0;
    if (!p.next(0, cur)) return;
    f32x4 acc[2][2][4][2];
#pragma unroll
    for (int a = 0; a < 2; ++a)
#pragma unroll
        for (int b = 0; b < 2; ++b)
#pragma unroll
            for (int m = 0; m < 4; ++m)
#pragma unroll
                for (int n = 0; n < 2; ++n) acc[a][b][m][n] = (f32x4){0.f, 0.f, 0.f, 0.f};
    bf16x8 At[4][2], B0[2][2], B1[2][2];
    const char* cA = p.a_base(cur); const char* cB = p.b_base(cur);
    p.a_voff(cur, R0, R1, C0, C1, vA0, vA1);
    PG8_STAGE(PG8_SB(0, 0), cB, voffB); PG8_STAGE(PG8_SB(0, 1), cB + hstepB, voffB); PG8_STAGE(PG8_SA(0, 0), cA, vA0); PG8_STAGE(PG8_SA(0, 1), cA, vA1);
    if (wr == 1) PG8_BAR;
    PG8_WAIT_V(2); PG8_BAR;
    PG8_STAGE(PG8_SB(1, 0), cB + kstep, voffB); PG8_STAGE(PG8_SA(1, 0), cA + kstep, vA0); PG8_STAGE(PG8_SB(1, 1), cB + hstepB + kstep, voffB);
    PG8_WAIT_V(6); PG8_BAR;
    for (;;) {
        const bool has_next = p.next(ui + 1, nxt);
        const char* nA = has_next ? p.a_base(nxt) : cA; const char* nB = has_next ? p.b_base(nxt) : cB;
        for (int t = 0; t < nt; t += 2) {
            const bool last = (t == nt - 2);
            const char* a1 = cA + (size_t)(t + 1) * kstep;
            const char* a2 = last ? nA : cA + (size_t)(t + 2) * kstep; const char* b2 = last ? nB : cB + (size_t)(t + 2) * kstep;
            const char* a3 = a2 + kstep; const char* b3 = b2 + kstep;
            PG8_LDB(B0, 0, 0); PG8_LDB(B1, 0, 1); PG8_SCHED; PG8_LDA(At, 0, 0); PG8_STAGE(PG8_SA(1, 1), a1, vA1);
            if (last && has_next) p.a_voff(nxt, R0, R1, C0, C1, vA0, vA1);
            PG8_WAIT_V(8); PG8_WAIT_L(0); PG8_BAR; PG8_MMA(0, 0, At, B0); PG8_MMA(0, 1, At, B1); PG8_BAR; PG8_SCHED;
            PG8_LDA(At, 0, 1); PG8_STAGE(PG8_SB(0, 0), b2, voffB); PG8_STAGE(PG8_SB(0, 1), b2 + hstepB, voffB); PG8_STAGE(PG8_SA(0, 0), a2, vA0);
            PG8_WAIT_V(8); PG8_WAIT_L(0); PG8_BAR; PG8_MMA(1, 0, At, B0); PG8_MMA(1, 1, At, B1); PG8_BAR; PG8_SCHED;
            PG8_LDB(B0, 1, 0); PG8_LDB(B1, 1, 1); PG8_SCHED; PG8_LDA(At, 1, 0); PG8_STAGE(PG8_SA(0, 1), a2, vA1);
            PG8_WAIT_V(8); PG8_WAIT_L(0); PG8_BAR; PG8_MMA(0, 0, At, B0); PG8_MMA(0, 1, At, B1); PG8_BAR; PG8_SCHED;
            PG8_LDA(At, 1, 1); PG8_STAGE(PG8_SB(1, 0), b3, voffB); PG8_STAGE(PG8_SB(1, 1), b3 + hstepB, voffB); PG8_STAGE(PG8_SA(1, 0), a3, vA0);
            PG8_WAIT_V(8); PG8_WAIT_L(0); PG8_BAR; PG8_MMA(1, 0, At, B0); PG8_MMA(1, 1, At, B1); PG8_BAR; PG8_SCHED;
        }
        if (wr == 0) PG8_BAR;
        p.epi(acc, cur, wr, wc, fr, fq);
        if (!has_next) break;
#pragma unroll
        for (int a = 0; a < 2; ++a)
#pragma unroll
            for (int b = 0; b < 2; ++b)
#pragma unroll
                for (int m = 0; m < 4; ++m)
#pragma unroll
                    for (int n = 0; n < 2; ++n) acc[a][b][m][n] = (f32x4){0.f, 0.f, 0.f, 0.f};
        cur = nxt; cA = nA; cB = nB; ++ui;
        if (wr == 1) PG8_BAR;
    }
    PG8_WAIT_V(0);
    PG8_BAR;
#undef PG8_SA
#undef PG8_SB
#undef PG8_STAGE
#undef PG8_LDA
#undef PG8_LDB
#undef PG8_MMA
#undef PG8_WAIT_V
#undef PG8_WAIT_L
#undef PG8_BAR
#undef PG8_SCHED
}
}
using pg8::Unit;
typedef f32x4 AccT[2][2][4][2];

struct DenseA {
    const bf16* A; int lda;
    __device__ __forceinline__ const char* base(int pm) const { return (const char*)A + (size_t)pm * 256 * lda * 2; }
    __device__ __forceinline__ void voff(int R0, int R1, int C0, int C1, unsigned* v0, unsigned* v1) const {
        v0[0] = (unsigned)(R0 * lda + C0) * 2u; v0[1] = (unsigned)(R1 * lda + C1) * 2u; v1[0] = v0[0] + (unsigned)(128 * lda * 2); v1[1] = v0[1] + (unsigned)(128 * lda * 2); }
};
__device__ __forceinline__ u32x4 pack8(const f32x4& a, const f32x4& b) { u32x4 w; w.x = pk2(a[0], a[1]); w.y = pk2(a[2], a[3]); w.z = pk2(b[0], b[1]); w.w = pk2(b[2], b[3]); return w; }
__device__ __forceinline__ void unpack8(const u32x4& w, f32x4& a, f32x4& b) { a = (f32x4){bflo(w.x), bfhi(w.x), bflo(w.y), bfhi(w.y)}; b = (f32x4){bflo(w.z), bfhi(w.z), bflo(w.w), bfhi(w.w)}; }
#define EPI_FENCE() asm volatile("" ::: "memory")

struct PolG1 {
    static constexpr bool PERM = true;
    int K, G, c;
    const bf16* XB; const bf16* WT; const float* rstd1; const float* qn; const float* kn; const float* rope;
    bf16 *Q, *Kb, *V, *UA, *GT;
    __device__ __forceinline__ bool next(int i, Unit& u) const { u.e = 0; u.row0 = 0; return pg8::static_order(128, 19, G, c, i, u.pm, u.pn); }
    __device__ __forceinline__ int tok0(const Unit& u, int& sh) const {
        if (u.pn >= 9) { sh = 0; return u.pm * 256; }
        sh = 2 * (u.pn % 3); const int pr0 = u.pm * 256, b = pr0 >> 14, q = pr0 & 16383, rr = q >> (14 - sh), i0 = q & ((16384 >> sh) - 1);
        return (b << 14) + (i0 << sh) + rr;
    }
    __device__ __forceinline__ const char* a_base(const Unit& u) const { int sh; const int t0 = tok0(u, sh); return (const char*)XB + (size_t)t0 * 2048; }
    __device__ __forceinline__ void a_voff(const Unit& u, int R0, int R1, int C0, int C1, unsigned* v0, unsigned* v1) const {
        int sh; (void)tok0(u, sh); const unsigned rs = 2048u << sh;
        v0[0] = (unsigned)R0 * rs + (unsigned)C0 * 2u; v0[1] = (unsigned)R1 * rs + (unsigned)C1 * 2u; v1[0] = v0[0] + 128u * rs; v1[1] = v0[1] + 128u * rs; }
    __device__ __forceinline__ const char* b_base(const Unit& u) const { return (const char*)WT + (size_t)u.pn * 256 * 1024 * 2; }
    __device__ __forceinline__ void epi(AccT& acc, const Unit& u, int wr, int wc, int fr, int fq) const {
        int sh; const int t0 = tok0(u, sh);
        if (u.pn < 6) {
            const int g = u.pn % 3, head = 4 * g + wc; const bool isq = u.pn < 3;
            const float* gain = (isq ? qn : kn) + head * 64; const float sc = isq ? QSCALE : 1.0f;
            bf16* dst = (isq ? Q : Kb) + (size_t)head * T * 64;
            f32x4 gv[2][2];
#pragma unroll
            for (int bj = 0; bj < 2; ++bj)
#pragma unroll
                for (int n = 0; n < 2; ++n) gv[bj][n] = *(const f32x4*)(gain + 32 * bj + 8 * fq + 4 * n);
#pragma unroll
            for (int ai = 0; ai < 2; ++ai)
#pragma unroll
                for (int m = 0; m < 4; ++m) {
                    const int r = 128 * ai + 64 * wr + 16 * m + fr, token = t0 + (r << sh), prow = u.pm * 256 + r; const float rs = rstd1[token];
                    f32x4 x[2][2]; float ss = 0.f;
#pragma unroll
                    for (int bj = 0; bj < 2; ++bj)
#pragma unroll
                        for (int n = 0; n < 2; ++n) { x[bj][n] = acc[ai][bj][m][n] * rs; const f32x4 q2 = x[bj][n] * x[bj][n]; ss += (q2[0] + q2[1]) + (q2[2] + q2[3]); }
                    ss += __shfl_xor(ss, 16); ss += __shfl_xor(ss, 32);
                    const float rn = rsqrtf(ss * (1.0f / 64.0f) + NORM_EPS) * sc;
                    const int pos = token & 16383; const f32x4* rp = (const f32x4*)(rope + ((size_t)pos * 32 + 8 * fq) * 2);
                    f32x4 olo[2], ohi[2];
#pragma unroll
                    for (int n = 0; n < 2; ++n) {
                        const f32x4 cs0 = rp[2 * n], cs1 = rp[2 * n + 1];
                        const f32x4 cv = {cs0[0], cs0[2], cs1[0], cs1[2]}, sv = {cs0[1], cs0[3], cs1[1], cs1[3]};
                        const f32x4 lo = x[0][n] * gv[0][n] * rn, hi = x[1][n] * gv[1][n] * rn;
                        olo[n] = lo * cv - hi * sv; ohi[n] = hi * cv + lo * sv;
                    }
                    bf16* rowp = dst + (size_t)prow * 64 + 8 * fq;
                    *(u32x4*)rowp = pack8(olo[0], olo[1]); *(u32x4*)(rowp + 32) = pack8(ohi[0], ohi[1]);
                    if (m & 1) EPI_FENCE();
                }
        } else if (u.pn < 9) {
            const int g = u.pn % 3, head = 4 * g + wc; bf16* dst = V + (size_t)head * T * 64;
#pragma unroll
            for (int ai = 0; ai < 2; ++ai)
#pragma unroll
                for (int m = 0; m < 4; ++m) {
                    const int r = 128 * ai + 64 * wr + 16 * m + fr, token = t0 + (r << sh), prow = u.pm * 256 + r; const float rs = rstd1[token];
                    bf16* rowp = dst + (size_t)prow * 64 + 8 * fq;
#pragma unroll
                    for (int bj = 0; bj < 2; ++bj) *(u32x4*)(rowp + 32 * bj) = pack8(acc[ai][bj][m][0] * rs, acc[ai][bj][m][1] * rs);
                }
        } else if (u.pn < 11) {
#pragma unroll
            for (int ai = 0; ai < 2; ++ai)
#pragma unroll
                for (int m = 0; m < 4; ++m) {
                    const int r = 128 * ai + 64 * wr + 16 * m + fr, token = t0 + r; const float rs = rstd1[token];
#pragma unroll
                    for (int bj = 0; bj < 2; ++bj) { const int col0 = 256 * (u.pn - 9) + 128 * bj + 32 * wc + 8 * fq, gq = col0 >> 4, ch0 = col0 & 15;
                        *(u32x4*)(UA + ((size_t)(gq * NCH + (token >> 6)) * KA2 + (token & 63) * 16 + ch0)) = pack8(acc[ai][bj][m][0] * rs, acc[ai][bj][m][1] * rs); }
                }
        } else {
#pragma unroll
            for (int ai = 0; ai < 2; ++ai)
#pragma unroll
                for (int m = 0; m < 4; ++m) {
                    const int r = 128 * ai + 64 * wr + 16 * m + fr, token = t0 + r; const float rs = rstd1[token];
#pragma unroll
                    for (int bj = 0; bj < 2; ++bj) { const int col0 = 256 * (u.pn - 11) + 128 * bj + 32 * wc + 8 * fq; f32x4 a = acc[ai][bj][m][0] * rs, b = acc[ai][bj][m][1] * rs;
#pragma unroll
                        for (int i = 0; i < 4; ++i) { a[i] = sigmoidf_(a[i]); b[i] = sigmoidf_(b[i]); }
                        *(u32x4*)(GT + (size_t)token * 2048 + col0) = pack8(a, b); }
                }
        }
    }
};

struct PolS5a {
    static constexpr bool PERM = false;
    int K, G, c; const bf16* UA; const bf16* BT1; float* E;
    __device__ __forceinline__ bool next(int i, Unit& u) const { const int L = i * G + c; if (L >= 64) return false; u.e = L >> 1; u.pm = L & 1; u.pn = 0; u.row0 = 0; return true; }
    __device__ __forceinline__ const char* a_base(const Unit& u) const { return (const char*)UA + (size_t)(u.e * NCH + u.pm * 256) * KA2 * 2; }
    __device__ __forceinline__ void a_voff(const Unit&, int R0, int R1, int C0, int C1, unsigned* v0, unsigned* v1) const { DenseA d{nullptr, KA2}; d.voff(R0, R1, C0, C1, v0, v1); }
    __device__ __forceinline__ const char* b_base(const Unit& u) const { return (const char*)BT1 + (size_t)u.e * 256 * 1024 * 2; }
    __device__ __forceinline__ void epi(AccT& acc, const Unit& u, int wr, int wc, int fr, int fq) const {
#pragma unroll
        for (int ai = 0; ai < 2; ++ai)
#pragma unroll
            for (int m = 0; m < 4; ++m) { const int r = 128 * ai + 64 * wr + 16 * m + fr; float* rowp = E + (size_t)(u.e * NCH + u.pm * 256 + r) * 256 + 32 * wc + 4 * fq;
#pragma unroll
                for (int bj = 0; bj < 2; ++bj)
#pragma unroll
                    for (int n = 0; n < 2; ++n) *(f32x4*)(rowp + 128 * bj + 16 * n) = acc[ai][bj][m][n]; }
    }
};
struct PolS5b {
    static constexpr bool PERM = true;
    int K, G, vcu; const bf16* UA; const bf16* BT2; bf16* Z;
    __device__ __forceinline__ bool next(int i, Unit& u) const { const int L = i * G + vcu; if (L >= 256) return false; u.e = L >> 3; u.pm = (L >> 2) & 1; u.pn = L & 3; u.row0 = 0; return true; }
    __device__ __forceinline__ const char* a_base(const Unit& u) const { return (const char*)UA + (size_t)(u.e * NCH + u.pm * 256) * KA2 * 2; }
    __device__ __forceinline__ void a_voff(const Unit&, int R0, int R1, int C0, int C1, unsigned* v0, unsigned* v1) const { DenseA d{nullptr, KA2}; d.voff(R0, R1, C0, C1, v0, v1); }
    __device__ __forceinline__ const char* b_base(const Unit& u) const { return (const char*)BT2 + (size_t)(u.e * 1024 + u.pn * 256) * KA2 * 2; }
    __device__ __forceinline__ void epi(AccT& acc, const Unit& u, int wr, int wc, int fr, int fq) const {
#pragma unroll
        for (int ai = 0; ai < 2; ++ai)
#pragma unroll
            for (int m = 0; m < 4; ++m) { const int r = 128 * ai + 64 * wr + 16 * m + fr, chunk = u.pm * 256 + r;
#pragma unroll
                for (int bj = 0; bj < 2; ++bj) { const int tl = 16 * u.pn + 8 * bj + 2 * wc + (fq >> 1), c0 = 8 * (fq & 1); f32x4 a = acc[ai][bj][m][0], b = acc[ai][bj][m][1];
#pragma unroll
                    for (int i = 0; i < 4; ++i) { a[i] = gelu_tanh(a[i]); b[i] = gelu_tanh(b[i]); }
                    *(u32x4*)(Z + (size_t)(chunk * 64 + tl) * SSMW + u.e * 16 + c0) = pack8(a, b); } }
    }
};
template <int KIND> struct PolDense {
    static constexpr bool PERM = (KIND != 3);
    int K, G, c, nN; DenseA A; const bf16* Bt;
    const bf16* in0; const bf16* in1; const float* fin; const float* bias; bf16* o16; float* o32;
    __device__ __forceinline__ bool next(int i, Unit& u) const { u.e = 0; u.row0 = 0; return pg8::static_order(128, nN, G, c, i, u.pm, u.pn); }
    __device__ __forceinline__ const char* a_base(const Unit& u) const { return A.base(u.pm); }
    __device__ __forceinline__ void a_voff(const Unit&, int R0, int R1, int C0, int C1, unsigned* v0, unsigned* v1) const { A.voff(R0, R1, C0, C1, v0, v1); }
    __device__ __forceinline__ const char* b_base(const Unit& u) const { return (const char*)Bt + (size_t)u.pn * 256 * K * 2; }
    __device__ __forceinline__ void epi(AccT& acc, const Unit& u, int wr, int wc, int fr, int fq) const {
#pragma unroll
        for (int ai = 0; ai < 2; ++ai)
#pragma unroll
            for (int m = 0; m < 4; ++m) { const int row = u.pm * 256 + 128 * ai + 64 * wr + 16 * m + fr;
#pragma unroll
                for (int bj = 0; bj < 2; ++bj) {
                    if constexpr (KIND == 0) {
                        const int col = u.pn * 256 + 128 * bj + 32 * wc + 8 * fq; f32x4 za, zb; unpack8(*(const u32x4*)(in0 + (size_t)row * SSMW + col), za, zb);
                        f32x4 a = acc[ai][bj][m][0] + *(const f32x4*)(bias + col), b = acc[ai][bj][m][1] + *(const f32x4*)(bias + col + 4);
#pragma unroll
                        for (int i = 0; i < 4; ++i) { a[i] = za[i] * sigmoidf_(a[i]); b[i] = zb[i] * sigmoidf_(b[i]); }
                        *(u32x4*)(o16 + (size_t)row * SSMW + col) = pack8(a, b);
                    } else if constexpr (KIND == 1) {
                        const int col = u.pn * 256 + 128 * bj + 32 * wc + 8 * fq; f32x4 ga, gb; unpack8(*(const u32x4*)(in0 + (size_t)row * 2048 + col), ga, gb);
                        *(u32x4*)(o16 + (size_t)row * DM + col) = pack8(acc[ai][bj][m][0] * ga, acc[ai][bj][m][1] * gb);
                    } else if constexpr (KIND == 2) {
                        const int col = u.pn * 256 + 128 * bj + 32 * wc + 8 * fq; f32x4 ga, gb, ta, tb; unpack8(*(const u32x4*)(in0 + (size_t)row * 2048 + 1024 + col), ga, gb); unpack8(*(const u32x4*)(in1 + (size_t)row * DM + col), ta, tb);
                        *(u32x4*)(o16 + (size_t)row * DM + col) = pack8(ta + acc[ai][bj][m][0] * ga, tb + acc[ai][bj][m][1] * gb);
                    } else {
#pragma unroll
                        for (int n = 0; n < 2; ++n) { const int col = u.pn * 256 + 128 * bj + 32 * wc + 16 * n + 4 * fq; const f32x4 v = *(const f32x4*)(fin + (size_t)row * DM + col) + acc[ai][bj][m][n];
                            *(f32x4*)(o32 + (size_t)row * DM + col) = v; u32x2 w; w.x = pk2(v[0], v[1]); w.y = pk2(v[2], v[3]); *(u32x2*)(o16 + (size_t)row * DM + col) = w; }
                    }
                }
                if (m & 1) EPI_FENCE(); }
    }
};
__device__ __forceinline__ bool moe_next(const LAS int* tp, int npn_log, int G, int vcu, int i, Unit& u) {
    const int L = i * G + vcu, tiles = tp[32]; if (L >= (tiles << npn_log)) return false;
    const int tile = L >> npn_log; u.pn = L & ((1 << npn_log) - 1); int e = 0;
#pragma unroll 1
    for (int k = 1; k < 32; ++k) e += (tile >= tp[k]) ? 1 : 0;
    u.e = e; u.pm = tile - tp[e]; u.row0 = tile * 256; return true;
}
struct PolMoeGU {
    static constexpr bool PERM = true;
    int K, G, vcu; const LAS int* tp; const bf16* X1B; const bf16* WGU; const int* rowtok; const float* rstd2; const float* bgu; bf16* ACT;
    __device__ __forceinline__ bool next(int i, Unit& u) const { return moe_next(tp, 3, G, vcu, i, u); }
    __device__ __forceinline__ const char* a_base(const Unit&) const { return (const char*)X1B; }
    __device__ __forceinline__ void a_voff(const Unit& u, int R0, int R1, int C0, int C1, unsigned* v0, unsigned* v1) const {
        const int* rt = rowtok + u.row0;
        v0[0] = (unsigned)rt[R0] * 2048u + (unsigned)C0 * 2u; v0[1] = (unsigned)rt[R1] * 2048u + (unsigned)C1 * 2u;
        v1[0] = (unsigned)rt[128 + R0] * 2048u + (unsigned)C0 * 2u; v1[1] = (unsigned)rt[128 + R1] * 2048u + (unsigned)C1 * 2u; }
    __device__ __forceinline__ const char* b_base(const Unit& u) const { return (const char*)WGU + (size_t)(u.e * 2048 + u.pn * 256) * 1024 * 2; }
    __device__ __forceinline__ void epi(AccT& acc, const Unit& u, int wr, int wc, int fr, int fq) const {
        const int colg = u.pn * 128 + 32 * wc + 8 * fq; const float* bg = bgu + (size_t)u.e * 2048 + colg;
        const f32x4 bg0 = *(const f32x4*)bg, bg1 = *(const f32x4*)(bg + 4), bu0 = *(const f32x4*)(bg + 1024), bu1 = *(const f32x4*)(bg + 1028);
#pragma unroll
        for (int ai = 0; ai < 2; ++ai)
#pragma unroll
            for (int m = 0; m < 4; ++m) { const int row = u.row0 + 128 * ai + 64 * wr + 16 * m + fr; const float rs = rstd2[rowtok[row]];
                f32x4 ga = acc[ai][0][m][0] * rs + bg0, gb = acc[ai][0][m][1] * rs + bg1, ua = acc[ai][1][m][0] * rs + bu0, ub = acc[ai][1][m][1] * rs + bu1;
#pragma unroll
                for (int i = 0; i < 4; ++i) { float g1 = fminf(ga[i], 7.0f), u1 = fminf(fmaxf(ua[i], -7.0f), 7.0f); ga[i] = g1 * sigmoidf_(1.702f * g1) * (u1 + 1.0f);
                                              float g2 = fminf(gb[i], 7.0f), u2 = fminf(fmaxf(ub[i], -7.0f), 7.0f); gb[i] = g2 * sigmoidf_(1.702f * g2) * (u2 + 1.0f); }
                *(u32x4*)(ACT + (size_t)row * 1024 + colg) = pack8(ga, gb);
                if (m & 1) EPI_FENCE(); }
    }
};
struct PolMoeDN {
    static constexpr bool PERM = true;
    int K, G, vcu; const LAS int* tp; const bf16* ACT; const bf16* WD; const int* rowdst; const float* roww; const float* bd; bf16* Y4;
    __device__ __forceinline__ bool next(int i, Unit& u) const { return moe_next(tp, 2, G, vcu, i, u); }
    __device__ __forceinline__ const char* a_base(const Unit& u) const { return (const char*)ACT + (size_t)u.row0 * 2048; }
    __device__ __forceinline__ void a_voff(const Unit&, int R0, int R1, int C0, int C1, unsigned* v0, unsigned* v1) const { DenseA d{nullptr, 1024}; d.voff(R0, R1, C0, C1, v0, v1); }
    __device__ __forceinline__ const char* b_base(const Unit& u) const { return (const char*)WD + (size_t)(u.e * 1024 + u.pn * 256) * 1024 * 2; }
    __device__ __forceinline__ void epi(AccT& acc, const Unit& u, int wr, int wc, int fr, int fq) const {
#pragma unroll
        for (int ai = 0; ai < 2; ++ai)
#pragma unroll
            for (int m = 0; m < 4; ++m) { const int row = u.row0 + 128 * ai + 64 * wr + 16 * m + fr; const int dst = rowdst[row]; const float w = roww[row];
                if (dst >= 0) {
#pragma unroll
                    for (int bj = 0; bj < 2; ++bj) { const int col = u.pn * 256 + 128 * bj + 32 * wc + 8 * fq; const float* bb = bd + (size_t)u.e * 1024 + col;
                        *(u32x4*)(Y4 + (size_t)dst * 1024 + col) = pack8((acc[ai][bj][m][0] + *(const f32x4*)bb) * w, (acc[ai][bj][m][1] + *(const f32x4*)(bb + 4)) * w); } }
                if (m & 1) EPI_FENCE(); }
    }
};

struct Args { const float* in[25]; float* out; unsigned char* ws; int ph_lo, ph_hi; };
enum { I_X = 0, I_NORM1, I_WIN, I_QN, I_KN, I_LRE, I_LIM, I_LDT, I_BRE, I_BIM, I_CRE, I_CIM, I_DSK, I_WGLU, I_BGLU, I_WA, I_WS, I_WO, I_NORM2, I_WR, I_BR, I_WGU, I_BGU, I_WD, I_BD };

__device__ __forceinline__ int tr_dstrow(int mode, int n) {
    if (mode == 1) { if (n >= 2304) return n; const int pn = n >> 8, np = n & 255, hh = np >> 6, dd = np & 63; return (pn << 8) + 128 * (dd >> 5) + 32 * hh + (dd & 31); }
    if (mode == 2) { if (n < 1024) return ((n >> 7) << 8) + (n & 127); const int u = n - 1024; return ((u >> 7) << 8) + 128 + (u & 127); }
    return n;
}
__device__ __forceinline__ void p0_transpose_item(const float* W, int K, int N, bf16* WT, int mode, const float* ksc, LAS float* scr, int item, int lane) {
    const int nblk = N / 32, kb = item / nblk, nb = item % nblk, k0 = 64 * kb, n0 = 32 * nb;
#pragma unroll 8
    for (int i = 0; i < 32; ++i) { const int kk = 2 * i + (lane >> 5); float v = W[(size_t)(k0 + kk) * N + n0 + (lane & 31)]; if (ksc) v *= ksc[k0 + kk]; scr[kk * 33 + (lane & 31)] = v; }
    LDS_WAIT(); asm volatile("" ::: "memory");
    const int c = lane & 7;
#pragma unroll
    for (int j = 0; j < 4; ++j) { const int n = (lane >> 3) + 8 * j; const LAS float* s = scr + (8 * c) * 33 + n;
        u32x4 o; o.x = pk2(s[0 * 33], s[1 * 33]); o.y = pk2(s[2 * 33], s[3 * 33]); o.z = pk2(s[4 * 33], s[5 * 33]); o.w = pk2(s[6 * 33], s[7 * 33]);
        *(u32x4*)(WT + (size_t)tr_dstrow(mode, n0 + n) * K + k0 + 8 * c) = o; }
    LDS_WAIT(); asm volatile("" ::: "memory");
}
__device__ __forceinline__ void s5_mode(const Args& a, int g, int dir, int p, double& lr, double& li, double& dt) {
    const int gi = dir * NG + g; dt = exp((double)a.in[I_LDT][gi]); lr = (double)a.in[I_LRE][gi * NP + p]; li = (double)a.in[I_LIM][gi * NP + p];
}
__device__ __forceinline__ void p0_prologue(const Args& a, LAS unsigned char* lds, int tid, int lane, int wave, int vcu, int G) {
    unsigned char* ws = a.ws;
    const int gw = vcu * NWAVES + wave, NGW = G * NWAVES, gt = vcu * NTHREADS + tid, NT = G * NTHREADS;
    {
        const int g = vcu >> 3, s = vcu & 7;
        LAS f32x2* Cc = (LAS f32x2*)lds;
        LAS f32x2* Bf = (LAS f32x2*)(lds + 16384);
        LAS f32x2* Pw = (LAS f32x2*)(lds + 32768);
        LAS f32x2* Fm = (LAS f32x2*)(lds + 32768 + 8192);
        if (vcu < 256) {
            for (int i = tid; i < 2048; i += NTHREADS) { const int dir = i >> 10, c = (i >> 6) & 15, p = i & 63; const int src = ((dir * NG + g) * GC + c) * NP + p; Cc[i] = (f32x2){a.in[I_CRE][src], a.in[I_CIM][src]}; }
            if (tid < 128) { const int dir = tid >> 6, p = tid & 63; double lr, li, dt; s5_mode(a, g, dir, p, lr, li, dt);
                const double mag = exp(lr * dt), ar = mag * cos(li * dt), ai = mag * sin(li * dt), nr = ar - 1.0, den = lr * lr + li * li;
                Fm[tid] = (f32x2){(float)((nr * lr + ai * li) / den), (float)((ai * lr - nr * li) / den)}; }
            for (int i = tid; i < 1024; i += NTHREADS) { const int k = i >> 6, p = i & 63, ts = 16 * s + k - 63, dir = ts >= 0 ? 0 : 1, e = ts >= 0 ? ts : -ts;
                double lr, li, dt; s5_mode(a, g, dir, p, lr, li, dt); const double mag = exp(lr * dt * e), ang = li * dt * e; Pw[i] = (f32x2){(float)(mag * cos(ang)), (float)(mag * sin(ang))}; }
            __syncthreads();
            for (int i = tid; i < 2048; i += NTHREADS) { const int dir = i >> 10, p = (i >> 4) & 63, cp = i & 15; const int src = ((dir * NG + g) * NP + p) * GC + cp;
                const float br = a.in[I_BRE][src], bi = a.in[I_BIM][src]; const f32x2 f = Fm[dir * 64 + p]; Bf[i] = (f32x2){f.x * br - f.y * bi, f.x * bi + f.y * br}; }
            __syncthreads();
            const int k = tid >> 5, c = (tid >> 1) & 15, hf = tid & 1, tp = 16 * s + k, ts = tp - 63;
            if (tp < 127) {
                float acc[8];
#pragma unroll
                for (int j = 0; j < 8; ++j) acc[j] = 0.f;
                for (int dir = 0; dir < 2; ++dir) {
                    if (ts > 0 && dir == 1) continue; if (ts < 0 && dir == 0) continue;
                    for (int p = 0; p < 64; ++p) { const f32x2 cc = Cc[(dir * 16 + c) * 64 + p]; f32x2 w = cc; if (ts != 0) { const f32x2 pw = Pw[k * 64 + p]; w = (f32x2){cc.x * pw.x - cc.y * pw.y, cc.x * pw.y + cc.y * pw.x}; }
#pragma unroll
                        for (int j = 0; j < 8; ++j) { const f32x2 b = Bf[(dir * 64 + p) * 16 + 8 * hf + j]; acc[j] += w.x * b.x - w.y * b.y; } }
                }
                if (ts == 0) {
#pragma unroll
                    for (int j = 0; j < 8; ++j) if (8 * hf + j == c) acc[j] += a.in[I_DSK][g * GC + c]; }
                float* kt = (float*)(ws + WS_KT) + ((size_t)(g * 127 + tp) * 16 + c) * 16 + 8 * hf;
                *(f32x4*)kt = (f32x4){acc[0], acc[1], acc[2], acc[3]}; *(f32x4*)(kt + 4) = (f32x4){acc[4], acc[5], acc[6], acc[7]};
            }
            __syncthreads();
        }
    }
    {
        LAS float* scr = (LAS float*)(lds + wave * 16384);
        constexpr int I0 = 16 * 152, I1 = I0 + 8 * 16, I2 = I1 + 4 * 32, I3 = I2 + 8 * 32, I4 = I3 + 16 * 32, I5 = I4 + 32 * 16 * 64, I6 = I5 + 32 * 16 * 32;
        for (int it = gw; it < I6; it += NGW) {
            if (it < I0) p0_transpose_item(a.in[I_WIN], 1024, INW, (bf16*)(ws + WS_WIN), 1, a.in[I_NORM1], scr, it, lane);
            else if (it < I1) p0_transpose_item(a.in[I_WGLU], 512, 512, (bf16*)(ws + WS_WGLU), 0, nullptr, scr, it - I0, lane);
            else if (it < I2) p0_transpose_item(a.in[I_WA], 256, 1024, (bf16*)(ws + WS_WA), 0, nullptr, scr, it - I1, lane);
            else if (it < I3) p0_transpose_item(a.in[I_WS], 512, 1024, (bf16*)(ws + WS_WS), 0, nullptr, scr, it - I2, lane);
            else if (it < I4) p0_transpose_item(a.in[I_WO], 1024, 1024, (bf16*)(ws + WS_WO), 0, nullptr, scr, it - I3, lane);
            else if (it < I5) { const int r = it - I4, e = r >> 10; p0_transpose_item(a.in[I_WGU] + (size_t)e * 1024 * 2048, 1024, 2048, (bf16*)(ws + WS_WGU) + (size_t)e * 2048 * 1024, 2, a.in[I_NORM2], scr, r & 1023, lane); }
            else { const int r = it - I5, e = r >> 9; p0_transpose_item(a.in[I_WD] + (size_t)e * 1024 * 1024, 1024, 1024, (bf16*)(ws + WS_WD) + (size_t)e * 1024 * 1024, 0, nullptr, scr, r & 511, lane); }
        }
    }
    for (int m = gw; m < T; m += NGW) {
        const f32x4* xr = (const f32x4*)(a.in[I_X] + (size_t)m * DM) + lane; f32x4 v[4]; float s = 0.f;
#pragma unroll
        for (int j = 0; j < 4; ++j) { v[j] = xr[64 * j]; s += (v[j][0] * v[j][0] + v[j][1] * v[j][1]) + (v[j][2] * v[j][2] + v[j][3] * v[j][3]); }
        const float tot = wave_sum(s); if (lane == 0) ((float*)(ws + WS_RSTD1))[m] = rsqrtf(tot * (1.0f / DM) + NORM_EPS);
        u32x2* o8 = (u32x2*)((bf16*)(ws + WS_XB) + (size_t)m * DM) + lane;
#pragma unroll
        for (int j = 0; j < 4; ++j) { u32x2 w; w.x = pk2(v[j][0], v[j][1]); w.y = pk2(v[j][2], v[j][3]); o8[64 * j] = w; }
    }
    for (int idx = gt; idx < SEQ * 32; idx += NT) { const int pos = idx >> 5, i = idx & 31; const double ang = (double)pos * exp(-(double)i * (9.210340371976184 / 32.0));
        ((f32x2*)(ws + WS_ROPE))[idx] = (f32x2){(float)cos(ang), (float)sin(ang)}; }
    for (int idx = gt; idx < NG * 2 * NP * 65; idx += NT) { const int e = idx % 65, gp = idx / 65, p = gp & 63, dir = (gp >> 6) & 1, g = gp >> 7; double lr, li, dt; s5_mode(a, g, dir, p, lr, li, dt);
        const double mag = exp(lr * dt * e), ang = li * dt * e; ((f32x2*)(ws + WS_POW))[idx] = (f32x2){(float)(mag * cos(ang)), (float)(mag * sin(ang))}; }
    for (int idx = gt; idx < NG * 2 * NP; idx += NT) { const int p = idx & 63, dir = (idx >> 6) & 1, g = idx >> 7; double lr, li, dt; s5_mode(a, g, dir, p, lr, li, dt);
        const double mag = exp(lr * dt), ar = mag * cos(li * dt), ai = mag * sin(li * dt), nr = ar - 1.0, den = lr * lr + li * li; const float fr = (float)((nr * lr + ai * li) / den), fi = (float)((ai * lr - nr * li) / den);
        for (int cp = 0; cp < 16; ++cp) { const int src = ((dir * NG + g) * NP + p) * GC + cp; const float br = a.in[I_BRE][src], bi = a.in[I_BIM][src]; ((f32x2*)(ws + WS_BF))[idx * 16 + cp] = (f32x2){fr * br - fi * bi, fr * bi + fi * br}; } }
}
__device__ __forceinline__ void p1_expand(const Args& a, int gt, int NT) {
    unsigned char* ws = a.ws; const float* KT = (const float*)(ws + WS_KT); const f32x2* POW = (const f32x2*)(ws + WS_POW); const f32x2* BF = (const f32x2*)(ws + WS_BF);
    bf16* BT2 = (bf16*)(ws + WS_BT2); bf16* BT1 = (bf16*)(ws + WS_BT1);
    for (int idx = gt; idx < NG * 1024 * 160; idx += NT) {
        const int k8 = idx % 160, n = (idx / 160) & 1023, g = idx / 163840, tl = n >> 4, c = n & 15; u32x4 o;
        if (k8 < 128) { const int kp = k8 >> 1, c0 = 8 * (k8 & 1); const float* s = KT + ((size_t)(g * 127 + (tl - kp + 63)) * 16 + c) * 16 + c0; o = pack8(*(const f32x4*)s, *(const f32x4*)(s + 4)); }
        else { const int kk = (k8 - 128) * 8, seg = kk >> 6, p0 = kk & 63, dir = seg >> 1, e = dir == 0 ? tl + 1 : 64 - tl; float v[8];
#pragma unroll
            for (int j = 0; j < 8; ++j) { const int p = p0 + j, src = ((dir * NG + g) * GC + c) * NP + p; const float cr = a.in[I_CRE][src], ci = a.in[I_CIM][src]; const f32x2 pw = POW[(size_t)((g * 2 + dir) * 64 + p) * 65 + e];
                v[j] = (seg & 1) ? -(cr * pw.y + ci * pw.x) : (cr * pw.x - ci * pw.y); }
            o.x = pk2(v[0], v[1]); o.y = pk2(v[2], v[3]); o.z = pk2(v[4], v[5]); o.w = pk2(v[6], v[7]); }
        *(u32x4*)(BT2 + ((size_t)(g * 1024 + n) * KA2 + 8 * k8)) = o;
    }
    for (int idx = gt; idx < NG * 256 * 128; idx += NT) {
        const int k8 = idx & 127, n = (idx >> 7) & 255, g = idx >> 15, kl = k8 >> 1, c0 = 8 * (k8 & 1), seg = n >> 6, p = n & 63, dir = seg >> 1, e = dir == 0 ? 63 - kl : kl;
        const f32x2 pw = POW[(size_t)((g * 2 + dir) * 64 + p) * 65 + e]; float v[8];
#pragma unroll
        for (int j = 0; j < 8; ++j) { const f32x2 b = BF[(size_t)((g * 2 + dir) * 64 + p) * 16 + c0 + j]; v[j] = (seg & 1) ? (pw.x * b.y + pw.y * b.x) : (pw.x * b.x - pw.y * b.y); }
        u32x4 o; o.x = pk2(v[0], v[1]); o.y = pk2(v[2], v[3]); o.z = pk2(v[4], v[5]); o.w = pk2(v[6], v[7]);
        *(u32x4*)(BT1 + ((size_t)(g * 256 + n) * 1024 + 8 * k8)) = o;
    }
}
typedef short v4i16_t __attribute__((ext_vector_type(4)));
__device__ __forceinline__ void attn_unit(LAS unsigned char* lds, const bf16* Q, const bf16* Kb, const bf16* V, bf16* O, float* LSE, int hd, int qb, int tid) {
    const int lane = tid & 63, w = __builtin_amdgcn_readfirstlane(tid >> 6), q = lane & 31, h = lane >> 5;
    const int g = hd >> 2, sh = 2 * g, Ls = SEQ >> sh, prow0 = qb * 256, seq0 = prow0 & ~(Ls - 1);
    const bf16* Kg = Kb + (size_t)hd * T * 64; const bf16* Vg = V + (size_t)hd * T * 64; const bf16* Qg = Q + (size_t)hd * T * 64;
    constexpr int KP = 144;
    LAS unsigned char* Kl = lds; LAS unsigned char* Vl = lds + 384 * KP;
    for (int idx = tid; idx < 3072; idx += NTHREADS) { const int kr = idx >> 3, ch = idx & 7, prow = prow0 - 64 + kr; u32x4 kv = {0u, 0u, 0u, 0u}, vv = {0u, 0u, 0u, 0u};
        if (prow >= seq0 && prow < seq0 + Ls) { kv = *(const u32x4*)(Kg + (size_t)prow * 64 + ch * 8); vv = *(const u32x4*)(Vg + (size_t)prow * 64 + ch * 8); }
        *(LAS u32x4*)(Kl + kr * KP + ch * 16) = kv; *(LAS u32x4*)(Vl + kr * KP + ch * 16) = vv; }
    bf16x8 qf[4];
#pragma unroll
    for (int s = 0; s < 4; ++s) qf[s] = *(const bf16x8*)(Qg + (size_t)(prow0 + 32 * w + q) * 64 + 16 * s + 8 * h);
    __syncthreads();
    f32x16 sc[5];
#pragma unroll
    for (int kb = 0; kb < 5; ++kb) { f32x16 acc = {};
#pragma unroll
        for (int s = 0; s < 4; ++s) { const bf16x8 kf = *(const LAS bf16x8*)(Kl + (32 * w + 32 * kb + q) * KP + (16 * s + 8 * h) * 2); acc = __builtin_amdgcn_mfma_f32_32x32x16_bf16(kf, qf[s], acc, 0, 0, 0); }
        sc[kb] = acc; }
    const int qpos = prow0 + 32 * w + q - seq0; float m = -INFINITY;
#pragma unroll
    for (int kb = 0; kb < 5; ++kb)
#pragma unroll
        for (int r = 0; r < 16; ++r) { const int kpos = prow0 - 64 + 32 * w + 32 * kb + (r & 3) + 8 * (r >> 2) + 4 * h - seq0, d = qpos - kpos;
            const bool ok = (d <= 64) && (d >= -64) && (kpos >= 0) && (kpos < Ls); const float v = ok ? sc[kb][r] : -INFINITY; sc[kb][r] = v; m = fmaxf(m, v); }
    m = fmaxf(m, __shfl_xor(m, 32)); float l = 0.f;
#pragma unroll
    for (int kb = 0; kb < 5; ++kb)
#pragma unroll
        for (int r = 0; r < 16; ++r) { const float pv = exp2f(sc[kb][r] - m); sc[kb][r] = pv; l += pv; }
    l += __shfl_xor(l, 32);
    f32x16 o[2] = {f32x16{}, f32x16{}};
    const int qq = (lane & 15) >> 2, pp = lane & 3, blk = (lane >> 4) & 1;
#pragma unroll
    for (int kb = 0; kb < 5; ++kb)
#pragma unroll
        for (int s2 = 0; s2 < 2; ++s2) {
            u32x4 pw; pw.x = pk2(sc[kb][8 * s2 + 0], sc[kb][8 * s2 + 1]); pw.y = pk2(sc[kb][8 * s2 + 2], sc[kb][8 * s2 + 3]); pw.z = pk2(sc[kb][8 * s2 + 4], sc[kb][8 * s2 + 5]); pw.w = pk2(sc[kb][8 * s2 + 6], sc[kb][8 * s2 + 7]);
            const bf16x8 pf = __builtin_bit_cast(bf16x8, pw);
#pragma unroll
            for (int c = 0; c < 2; ++c) {
                const int row = 32 * w + 32 * kb + 16 * s2 + 4 * h + qq; LAS unsigned char* ad = Vl + row * KP + (32 * c + 16 * blk + 4 * pp) * 2;
                const v4i16_t v0 = __builtin_amdgcn_ds_read_tr16_b64_v4i16((LAS v4i16_t*)ad), v1 = __builtin_amdgcn_ds_read_tr16_b64_v4i16((LAS v4i16_t*)(ad + 8 * KP));
                const bf16x8 vf = {v0[0], v0[1], v0[2], v0[3], v1[0], v1[1], v1[2], v1[3]};
                o[c] = __builtin_amdgcn_mfma_f32_32x32x16_bf16(vf, pf, o[c], 0, 0, 0);
            } }
    const float inv = 1.0f / l, L2 = m + log2f(l);
    const int prow = prow0 + 32 * w + q, b = prow >> 14, pq = prow & 16383, rr = pq >> (14 - sh), ii = pq & (Ls - 1), token = (b << 14) + (ii << sh) + rr;
    bf16* orow = O + ((size_t)g * T + token) * 256 + (hd & 3) * 64;
#pragma unroll
    for (int c = 0; c < 2; ++c)
#pragma unroll
        for (int rb = 0; rb < 4; ++rb) { u32x2 wv; wv.x = pk2(o[c][4 * rb] * inv, o[c][4 * rb + 1] * inv); wv.y = pk2(o[c][4 * rb + 2] * inv, o[c][4 * rb + 3] * inv); *(u32x2*)(orow + 32 * c + 8 * rb + 4 * h) = wv; }
    if (h == 0) LSE[((size_t)g * T + token) * 4 + (hd & 3)] = L2;
    __syncthreads();
}
__device__ __forceinline__ void p3_scan_combine(const Args& a, int gt, int NT) {
    unsigned char* ws = a.ws;
    if (gt < 2 * NG * 128) {
        const int cn = gt & 127, g = (gt >> 7) & 31, b = gt >> 12, dir = cn >> 6, p = cn & 63;
        const f32x2 aL = ((const f32x2*)(ws + WS_POW))[(size_t)((g * 2 + dir) * 64 + p) * 65 + 64];
        const float* E = (const float*)(ws + WS_E) + (size_t)(g * NCH + b * CHB) * 256 + dir * 128 + p; bf16* U = (bf16*)(ws + WS_UA) + (size_t)(g * NCH + b * CHB) * KA2 + 1024 + dir * 128 + p;
        float sr = 0.f, si = 0.f;
        for (int jb = 0; jb < CHB; jb += 8) { float er[8], ei[8];
#pragma unroll
            for (int u = 0; u < 8; ++u) { const int j = dir == 0 ? jb + u : CHB - 1 - (jb + u); er[u] = E[(size_t)j * 256]; ei[u] = E[(size_t)j * 256 + 64]; }
#pragma unroll
            for (int u = 0; u < 8; ++u) { const int j = dir == 0 ? jb + u : CHB - 1 - (jb + u); U[(size_t)j * KA2] = (bf16)f2bf(sr); U[(size_t)j * KA2 + 64] = (bf16)f2bf(si);
                const float nr = aL.x * sr - aL.y * si + er[u], ni = aL.x * si + aL.y * sr + ei[u]; sr = nr; si = ni; } }
    }
    const bf16* O = (const bf16*)(ws + WS_O); const float* LSE = (const float*)(ws + WS_LSE); bf16* AO = (bf16*)(ws + WS_AO);
    for (int idx = gt; idx < T * 32; idx += NT) { const int token = idx >> 5, j = (idx >> 3) & 3, ch = idx & 7;
        const float l0 = LSE[(size_t)token * 4 + j], l1 = LSE[((size_t)T + token) * 4 + j], l2 = LSE[((size_t)2 * T + token) * 4 + j], mx = fmaxf(l0, fmaxf(l1, l2));
        float w0 = exp2f(l0 - mx), w1 = exp2f(l1 - mx), w2 = exp2f(l2 - mx); const float ws_ = 1.0f / (w0 + w1 + w2); w0 *= ws_; w1 *= ws_; w2 *= ws_;
        const size_t off = (size_t)token * 256 + j * 64 + ch * 8; f32x4 a0, b0, a1, b1, a2, b2;
        unpack8(*(const u32x4*)(O + off), a0, b0); unpack8(*(const u32x4*)(O + (size_t)T * 256 + off), a1, b1); unpack8(*(const u32x4*)(O + (size_t)2 * T * 256 + off), a2, b2);
        *(u32x4*)(AO + off) = pack8(a0 * w0 + a1 * w1 + a2 * w2, b0 * w0 + b1 * w1 + b2 * w2); }
}
__device__ __forceinline__ void p8_router(const Args& a, LAS unsigned char* lds, int tid, int blk) {
    unsigned char* ws = a.ws; const int lane = tid & 63, w = __builtin_amdgcn_readfirstlane(tid >> 6), i = lane & 31, h = lane >> 5;
    LAS float* lg = (LAS float*)lds;
    LAS float* ssq = (LAS float*)(lds + 8 * 32 * 33 * 4);
    LAS int* hist = (LAS int*)(lds + 8 * 32 * 33 * 4 + 8 * 64 * 4);
    if (tid < 32) hist[tid] = 0;
    const int task = w & 3, kq = 2 * (w >> 2) + h, tok = blk * 128 + 32 * task + i;
    const float* xr = a.out + (size_t)tok * DM + 256 * kq; const float* g2 = a.in[I_NORM2] + 256 * kq; const float* wr = a.in[I_WR] + (size_t)(256 * kq) * NE + i;
    f32x16 acc = {}; float ss = 0.f;
#pragma unroll 2
    for (int kk = 0; kk < 256; kk += 4) { const f32x4 xv = *(const f32x4*)(xr + kk), gv = *(const f32x4*)(g2 + kk);
#pragma unroll
        for (int u = 0; u < 4; ++u) { acc = __builtin_amdgcn_mfma_f32_32x32x2f32(xv[u] * gv[u], wr[(size_t)(kk + u) * NE], acc, 0, 0, 0); ss += xv[u] * xv[u]; } }
#pragma unroll
    for (int r = 0; r < 16; ++r) lg[(w * 32 + (r & 3) + 8 * (r >> 2) + 4 * h) * 33 + i] = acc[r];
    ssq[w * 64 + lane] = ss;
    __syncthreads();
    if (w < 4 && lane < 32) {
        const float st = (ssq[w * 64 + i] + ssq[w * 64 + 32 + i]) + (ssq[(w + 4) * 64 + i] + ssq[(w + 4) * 64 + 32 + i]); const float rstd = rsqrtf(st * (1.0f / DM) + NORM_EPS);
        float v[32];
#pragma unroll
        for (int e = 0; e < 32; ++e) v[e] = (lg[(w * 32 + i) * 33 + e] + lg[((w + 4) * 32 + i) * 33 + e]) * rstd + a.in[I_BR][e];
        float tv[4]; int ti[4];
#pragma unroll
        for (int k = 0; k < 4; ++k) { float best = -INFINITY; int bi = 0;
#pragma unroll
            for (int e = 0; e < 32; ++e) if (v[e] > best) { best = v[e]; bi = e; }
#pragma unroll
            for (int e = 0; e < 32; ++e) if (e == bi) v[e] = -INFINITY;
            tv[k] = best; ti[k] = bi; }
        const float e1 = __expf(tv[1] - tv[0]), e2 = __expf(tv[2] - tv[0]), e3 = __expf(tv[3] - tv[0]), inv = 1.0f / (1.0f + e1 + e2 + e3);
        const int t2 = blk * 128 + 32 * w + i;
        ((float*)(ws + RT_RSTD2))[t2] = rstd;
        *(f32x4*)((float*)(ws + RT_TOPW) + (size_t)t2 * 4) = (f32x4){inv, e1 * inv, e2 * inv, e3 * inv};
        int* tip = (int*)(ws + RT_TOPI) + (size_t)t2 * 4; tip[0] = ti[0]; tip[1] = ti[1]; tip[2] = ti[2]; tip[3] = ti[3];
#pragma unroll
        for (int k = 0; k < 4; ++k) __hip_atomic_fetch_add(&hist[ti[k]], 1, __ATOMIC_RELAXED, __HIP_MEMORY_SCOPE_WORKGROUP);
    }
    __syncthreads();
    if (tid < 32) ((int*)(ws + RT_CNT))[blk * 32 + tid] = hist[tid];
}
__device__ __forceinline__ void p9_rowlists(const Args& a, LAS unsigned char* lds, int tid, int blk) {
    unsigned char* ws = a.ws; const int lane = tid & 63, w = __builtin_amdgcn_readfirstlane(tid >> 6);
    LAS int* part_all = (LAS int*)lds;
    LAS int* part_pre = part_all + 512;
    LAS int* tot = part_pre + 512;
    LAS int* pre = tot + 32;
    LAS int* base = pre + 32;
    LAS int* wcnt = base + 64;
    const int* CNT = (const int*)(ws + RT_CNT);
    { const int e = tid & 31, part = tid >> 5; int sa = 0, sp = 0;
      for (int bb = 16 * part; bb < 16 * part + 16; ++bb) { const int v = CNT[bb * 32 + e]; sa += v; if (bb < blk) sp += v; }
      part_all[part * 32 + e] = sa; part_pre[part * 32 + e] = sp; }
    __syncthreads();
    if (tid < 32) { int sa = 0, sp = 0; for (int part = 0; part < 16; ++part) { sa += part_all[part * 32 + tid]; sp += part_pre[part * 32 + tid]; } tot[tid] = sa; pre[tid] = sp; }
    __syncthreads();
    if (tid == 0) { int acc = 0; for (int e = 0; e < 32; ++e) { base[e] = acc; acc += (tot[e] + 255) & ~255; } base[32] = acc; }
    const int tok = blk * 128 + (tid >> 2), k = tid & 3; const int e = ((const int*)(ws + RT_TOPI))[(size_t)tok * 4 + k]; const float wv = ((const float*)(ws + RT_TOPW))[(size_t)tok * 4 + k];
    int rank = 0;
#pragma unroll 4
    for (int ee = 0; ee < 32; ++ee) { const unsigned long long mk = __ballot(e == ee); if (e == ee) rank = __popcll(mk & ((1ull << lane) - 1ull)); if (lane == 0) wcnt[w * 32 + ee] = __popcll(mk); }
    __syncthreads();
    int off = 0; for (int ww = 0; ww < w; ++ww) off += wcnt[ww * 32 + e];
    const int dest = base[e] + pre[e] + off + rank;
    ((int*)(ws + RT_ROWTOK))[dest] = tok; ((int*)(ws + RT_ROWDST))[dest] = tok * 4 + k; ((float*)(ws + RT_ROWW))[dest] = wv;
    if (blk == 0) {
        for (int ee = 0; ee < 32; ++ee) { const int s0 = base[ee] + tot[ee], s1 = base[ee + 1]; for (int r = s0 + tid; r < s1; r += NTHREADS) { ((int*)(ws + RT_ROWTOK))[r] = 0; ((int*)(ws + RT_ROWDST))[r] = -1; ((float*)(ws + RT_ROWW))[r] = 0.f; } }
        if (tid <= 32) ((int*)(ws + RT_META))[tid] = base[tid] >> 8;
    }
    __syncthreads();
}
__device__ __forceinline__ void p12_final(const Args& a, int gt, int NT) {
    const bf16* Y4 = (const bf16*)(a.ws + WS_Y4);
    for (int idx = gt; idx < T * 128; idx += NT) { const int token = idx >> 7, c8 = (idx & 127) * 8; float* o = a.out + (size_t)token * DM + c8; f32x4 va = *(const f32x4*)o, vb = *(const f32x4*)(o + 4);
#pragma unroll
        for (int k = 0; k < 4; ++k) { f32x4 ya, yb; unpack8(*(const u32x4*)(Y4 + ((size_t)token * 4 + k) * DM + c8), ya, yb); va += ya; vb += yb; }
        *(f32x4*)o = va; *(f32x4*)(o + 4) = vb; }
}

#define XB_TMO      128
#define XB_XCNT(j)  (256  + 64 * (j))
#define XB_XSUB(j)  (1280 + 64 * (j))
#define XB_XGEN(j)  (2304 + 64 * (j))
#define XB_TOP      3328
#define XB_TOPGEN   3392
#define XCD_BAR_WORDS 3456
#define XB_SPIN_CAP (1u << 18)
__device__ __forceinline__ unsigned xb_ld(unsigned* p)              { return __hip_atomic_load(p, __ATOMIC_RELAXED, __HIP_MEMORY_SCOPE_AGENT); }
__device__ __forceinline__ unsigned xb_add(unsigned* p, unsigned v) { return __hip_atomic_fetch_add(p, v, __ATOMIC_RELAXED, __HIP_MEMORY_SCOPE_AGENT); }
__device__ __forceinline__ unsigned xb_xcc_id() { return (unsigned)__builtin_amdgcn_s_getreg((3 << 11) | 20) & 0xFu; }
#define XB_SPIN(cond, bar) do { unsigned _sp = 0; while (cond) { __builtin_amdgcn_s_sleep(1); \
    if ((++_sp & 255u) == 0u) { if (xb_ld(&(bar)[XB_TMO])) break; if (_sp > XB_SPIN_CAP) { atomicAdd(&(bar)[XB_TMO], 1u); break; } } } } while (0)
struct XcdBarrier { unsigned* bar; unsigned x; volatile LAS unsigned* st; };
__device__ __forceinline__ XcdBarrier xcd_barrier_post(unsigned* bar, volatile LAS unsigned* st) {
    XcdBarrier b; b.bar = bar; b.x = xb_xcc_id(); b.st = st;
    if (threadIdx.x == 0) (void)xb_add(&bar[XB_XCNT(b.x)], 1u);
    return b;
}
__device__ __forceinline__ void xcd_barrier_complete(unsigned* bar, unsigned x, unsigned& nloc, unsigned& nx) {
    const unsigned G = gridDim.x * gridDim.y * gridDim.z;
    unsigned sum, cnt, mine, sp = 0u;
    for (;;) {
        sum = 0u; cnt = 0u; mine = 0u;
#pragma unroll
        for (unsigned j = 0; j < 16; ++j) { const unsigned c = xb_ld(&bar[XB_XCNT(j)]); sum += c; cnt += (c > 0u) ? 1u : 0u; mine = (j == x) ? c : mine; }
        if (sum == G) break;
        __builtin_amdgcn_s_sleep(1);
        if ((++sp & 255u) == 0u) { if (xb_ld(&bar[XB_TMO])) break; if (sp > XB_SPIN_CAP) { atomicAdd(&bar[XB_TMO], 1u); break; } }
    }
    nloc = mine > 0u ? mine : 1u; nx = cnt > 0u ? cnt : 1u;
}
__device__ __forceinline__ void xcd_barrier(const XcdBarrier& b) {
    asm volatile("s_waitcnt vmcnt(0)" ::: "memory");
    __syncthreads();
    if (threadIdx.x == 0) {
        unsigned* bar = b.bar;
        __builtin_amdgcn_s_waitcnt(0);
        unsigned nloc = b.st[0], nx = b.st[1];
        if (nloc == 0u) { xcd_barrier_complete(bar, b.x, nloc, nx); b.st[0] = nloc; b.st[1] = nx; }
        const unsigned old = xb_add(&bar[XB_XSUB(b.x)], 1u);
        const unsigned gen = old / nloc;
        if (old + 1u == (gen + 1u) * nloc) {
            __builtin_amdgcn_fence(__ATOMIC_RELEASE, "agent");
            asm volatile("s_waitcnt vmcnt(0)" ::: "memory");
            const unsigned og = xb_add(&bar[XB_TOP], 1u);
            const unsigned tg = og / nx;
            if (og + 1u == (tg + 1u) * nx) xb_add(&bar[XB_TOPGEN], 1u);
            else XB_SPIN(xb_ld(&bar[XB_TOPGEN]) == tg, bar);
            __builtin_amdgcn_fence(__ATOMIC_ACQUIRE, "agent");
            xb_add(&bar[XB_XGEN(b.x)], 1u);
            asm volatile("s_waitcnt vmcnt(0)" ::: "memory");
        } else {
            XB_SPIN(xb_ld(&bar[XB_XGEN(b.x)]) == gen, bar);
            __builtin_amdgcn_fence(__ATOMIC_ACQUIRE, "agent");
            asm volatile("s_waitcnt vmcnt(0)" ::: "memory");
        }
    }
    __syncthreads();
}

constexpr int N_PHASES = 13;
__global__ void __launch_bounds__(NTHREADS, 2) mega_fwd(Args args) {
    extern __shared__ __attribute__((aligned(16))) unsigned char lds_[];
    LAS unsigned char* lds = (LAS unsigned char*)lds_;
    volatile LAS unsigned* MISC = (volatile LAS unsigned*)(lds + MISC_OFF);
    const int tid = threadIdx.x, lane = tid & 63, wave = __builtin_amdgcn_readfirstlane(tid >> 6);
    const int G = gridDim.x, bx = blockIdx.x, vcu = (G % 8 == 0) ? (bx % 8) * (G / 8) + bx / 8 : bx;
    unsigned char* ws = args.ws; unsigned* ctl = (unsigned*)(ws + WS_CTL);
    for (int u = tid; u < (LDS_BYTES - LDSX_OFF) / 4; u += NTHREADS) ((LAS unsigned*)(lds + LDSX_OFF))[u] = 0u;
    __syncthreads();
    XcdBarrier bar; bar.bar = ctl + CW_BAR; bar.x = 0; bar.st = nullptr;
    if (MK_N_LAUNCHES == 1) bar = xcd_barrier_post(ctl + CW_BAR, MISC + 8);
    const int lo = args.ph_lo, hi = args.ph_hi;
#define IN(k) (lo <= (k) && (k) < hi)
#define SEAM(k) do { if (IN(k) && IN((k) + 1)) xcd_barrier(bar); } while (0)
    const int gt = vcu * NTHREADS + tid, NT = G * NTHREADS;
    const LAS int* tpre = (const LAS int*)(lds + TPRE_OFF);

    if (IN(0)) { p0_prologue(args, lds, tid, lane, wave, vcu, G); }
    SEAM(0);
    if (IN(1)) {
        p1_expand(args, gt, NT);
        PolG1 p; p.K = 1024; p.G = G; p.c = bx; p.XB = (const bf16*)(ws + WS_XB); p.WT = (const bf16*)(ws + WS_WIN); p.rstd1 = (const float*)(ws + WS_RSTD1);
        p.qn = args.in[I_QN]; p.kn = args.in[I_KN]; p.rope = (const float*)(ws + WS_ROPE);
        p.Q = (bf16*)(ws + WS_Q); p.Kb = (bf16*)(ws + WS_K); p.V = (bf16*)(ws + WS_V); p.UA = (bf16*)(ws + WS_UA); p.GT = (bf16*)(ws + WS_GATES);
        pg8::gemm_phase(lds, p);
    }
    SEAM(1);
    if (IN(2)) {
        { PolS5a p; p.K = 1024; p.G = G; p.c = bx; p.UA = (const bf16*)(ws + WS_UA); p.BT1 = (const bf16*)(ws + WS_BT1); p.E = (float*)(ws + WS_E); pg8::gemm_phase(lds, p); }
        __syncthreads();
        for (int L = vcu; L < NH * 128; L += G) attn_unit(lds, (const bf16*)(ws + WS_Q), (const bf16*)(ws + WS_K), (const bf16*)(ws + WS_V), (bf16*)(ws + WS_O), (float*)(ws + WS_LSE), L >> 7, L & 127, tid);
    }
    SEAM(2);
    if (IN(3)) { p3_scan_combine(args, gt, NT); }
    SEAM(3);
    if (IN(4)) { PolS5b p; p.K = KA2; p.G = G; p.vcu = vcu; p.UA = (const bf16*)(ws + WS_UA); p.BT2 = (const bf16*)(ws + WS_BT2); p.Z = (bf16*)(ws + WS_Z); pg8::gemm_phase(lds, p); }
    SEAM(4);
    if (IN(5)) {
        { PolDense<0> p; p.K = 512; p.G = G; p.c = bx; p.nN = 2; p.A = DenseA{(const bf16*)(ws + WS_Z), 512}; p.Bt = (const bf16*)(ws + WS_WGLU);
          p.in0 = (const bf16*)(ws + WS_Z); p.in1 = nullptr; p.fin = nullptr; p.bias = args.in[I_BGLU]; p.o16 = (bf16*)(ws + WS_GLU); p.o32 = nullptr; pg8::gemm_phase(lds, p); }
        { PolDense<1> p; p.K = 256; p.G = G; p.c = bx; p.nN = 4; p.A = DenseA{(const bf16*)(ws + WS_AO), 256}; p.Bt = (const bf16*)(ws + WS_WA);
          p.in0 = (const bf16*)(ws + WS_GATES); p.in1 = nullptr; p.fin = nullptr; p.bias = nullptr; p.o16 = (bf16*)(ws + WS_T1); p.o32 = nullptr; pg8::gemm_phase(lds, p); }
    }
    SEAM(5);
    if (IN(6)) { PolDense<2> p; p.K = 512; p.G = G; p.c = bx; p.nN = 4; p.A = DenseA{(const bf16*)(ws + WS_GLU), 512}; p.Bt = (const bf16*)(ws + WS_WS);
        p.in0 = (const bf16*)(ws + WS_GATES); p.in1 = (const bf16*)(ws + WS_T1); p.fin = nullptr; p.bias = nullptr; p.o16 = (bf16*)(ws + WS_MIXED); p.o32 = nullptr; pg8::gemm_phase(lds, p); }
    SEAM(6);
    if (IN(7)) { PolDense<3> p; p.K = 1024; p.G = G; p.c = bx; p.nN = 4; p.A = DenseA{(const bf16*)(ws + WS_MIXED), 1024}; p.Bt = (const bf16*)(ws + WS_WO);
        p.in0 = nullptr; p.in1 = nullptr; p.fin = args.in[I_X]; p.bias = nullptr; p.o16 = (bf16*)(ws + WS_X1B); p.o32 = args.out; pg8::gemm_phase(lds, p); }
    SEAM(7);
    if (IN(8)) { p8_router(args, lds, tid, bx); }
    SEAM(8);
    if (IN(9)) { p9_rowlists(args, lds, tid, bx); }
    SEAM(9);
    if (IN(10)) {
        if (tid <= 32) ((LAS int*)(lds + TPRE_OFF))[tid] = ((const int*)(ws + RT_META))[tid];
        __syncthreads();
        PolMoeGU p; p.K = 1024; p.G = G; p.vcu = vcu; p.tp = tpre; p.X1B = (const bf16*)(ws + WS_X1B); p.WGU = (const bf16*)(ws + WS_WGU); p.rowtok = (const int*)(ws + RT_ROWTOK);
        p.rstd2 = (const float*)(ws + RT_RSTD2); p.bgu = args.in[I_BGU]; p.ACT = (bf16*)(ws + WS_ACT); pg8::gemm_phase(lds, p);
    }
    SEAM(10);
    if (IN(11)) {
        if (tid <= 32) ((LAS int*)(lds + TPRE_OFF))[tid] = ((const int*)(ws + RT_META))[tid];
        __syncthreads();
        PolMoeDN p; p.K = 1024; p.G = G; p.vcu = vcu; p.tp = tpre; p.ACT = (const bf16*)(ws + WS_ACT); p.WD = (const bf16*)(ws + WS_WD); p.rowdst = (const int*)(ws + RT_ROWDST);
        p.roww = (const float*)(ws + RT_ROWW); p.bd = args.in[I_BD]; p.Y4 = (bf16*)(ws + WS_Y4); pg8::gemm_phase(lds, p);
    }
    SEAM(11);
    if (IN(12)) { p12_final(args, gt, NT); }
#undef IN
#undef SEAM
}

extern "C" void kernel_launch(void* const* d_in, const int* in_sizes, int n_in, void* d_out, int out_size, void* d_ws, size_t ws_size, hipStream_t stream) {
    static int grid = 0;
    if (grid == 0) {
        if (n_in != 25 || in_sizes[0] != T * DM || out_size != T * DM || ws_size < WS_END) {
            fprintf(stderr, "kernel_launch: unexpected shapes/workspace: n_in %d in0 %d out %d ws %zu (need %zu); nothing launched\n", n_in, n_in > 0 ? in_sizes[0] : -1, out_size, ws_size, (size_t)WS_END); grid = -1; return; }
        int dev = 0, cus = 0;
        if (hipGetDevice(&dev) != hipSuccess || hipDeviceGetAttribute(&cus, hipDeviceAttributeMultiprocessorCount, dev) != hipSuccess) { fprintf(stderr, "kernel_launch: device query failed\n"); grid = -1; return; }
        if (hipFuncSetAttribute((const void*)mega_fwd, hipFuncAttributeMaxDynamicSharedMemorySize, LDS_BYTES) != hipSuccess) { fprintf(stderr, "kernel_launch: hipFuncSetAttribute failed\n"); grid = -1; return; }
        int per_cu = 0;
        if (hipOccupancyMaxActiveBlocksPerMultiprocessor(&per_cu, (const void*)mega_fwd, NTHREADS, LDS_BYTES) != hipSuccess || per_cu < 1) fprintf(stderr, "kernel_launch: note: occupancy query reports %d blocks per CU\n", per_cu);
        (void)hipGetLastError();
        grid = cus;
        if (grid != 256) fprintf(stderr, "kernel_launch: built for a 256-CU device, got %d CUs\n", grid);
    }
    if (grid < 0) return;
    if (hipMemsetAsync((char*)d_ws + WS_CTL, 0, CTL_ZERO_BYTES, stream) != hipSuccess) { fprintf(stderr, "kernel_launch: memset failed\n"); return; }
    Args a{};
    for (int i = 0; i < 25; ++i) a.in[i] = (const float*)d_in[i];
    a.out = (float*)d_out; a.ws = (unsigned char*)d_ws;
    if (MK_N_LAUNCHES == 1) {
        a.ph_lo = 0; a.ph_hi = N_PHASES;
        hipLaunchKernelGGL(mega_fwd, dim3(grid), dim3(NTHREADS), LDS_BYTES, stream, a);
    } else {
        for (int ph = 0; ph < N_PHASES; ++ph) { a.ph_lo = ph; a.ph_hi = ph + 1; hipLaunchKernelGGL(mega_fwd, dim3(grid), dim3(NTHREADS), LDS_BYTES, stream, a); }
    }
    const hipError_t le = hipPeekAtLastError();
    if (le != hipSuccess) fprintf(stderr, "kernel_launch: launch failed: %s\n", hipGetErrorName(le));
}
```

```cpp
#include <hip/hip_runtime.h>
#include <cstdio>
#include <cstdint>

#ifndef MK_N_LAUNCHES
#define MK_N_LAUNCHES 1
#endif

#ifndef MOE_FP8
#define MOE_FP8 1
#endif
#ifndef REPEAT_MASK
#define REPEAT_MASK 0
#endif
#ifndef BAR_REP
#define BAR_REP 0
#endif
#ifndef P0_SUB
#define P0_SUB 0
#endif
#define P0REP(b) for (int rp_ = 0; rp_ < (((P0_SUB >> (b)) & 1) ? 2 : 1); ++rp_)
#define GAS __attribute__((address_space(1)))
#define LAS __attribute__((address_space(3)))
typedef unsigned short bf16;
typedef short bf16x8 __attribute__((ext_vector_type(8)));
typedef short s16x4 __attribute__((ext_vector_type(4)));
typedef float f32x2 __attribute__((ext_vector_type(2)));
typedef float f32x4 __attribute__((ext_vector_type(4)));
typedef float f32x16 __attribute__((ext_vector_type(16)));
typedef unsigned u32x2 __attribute__((ext_vector_type(2)));
typedef unsigned u32x4 __attribute__((ext_vector_type(4)));
typedef __bf16 bf16x2_t __attribute__((ext_vector_type(2)));

constexpr int T = 32768, DM = 1024, SEQ = 16384, NH = 12, HD = 64, INW = 4864;
constexpr int SSMW = 512, NG = 32, GC = 16, NP = 64;
constexpr int CL = 64, NCH = T / CL  , CHB = SEQ / CL  , KA2 = 1280;
constexpr int NE = 32, TOPK = 4, RMAX = T * TOPK + NE * 256;
constexpr float NORM_EPS = 1e-6f;
constexpr float QSCALE = 0.125f * 1.4426950408889634f;
constexpr int NWAVES = 8, NTHREADS = 512;

constexpr size_t MiB = 1u << 20;
constexpr size_t WS_CTL = 0, CTL_ZERO_BYTES = 1 * MiB;
constexpr size_t WS_WGU = 1 * MiB;
constexpr size_t WS_WD = WS_WGU + 128 * MiB;
constexpr size_t WS_X1B = WS_WD + 64 * MiB;
constexpr size_t WS_ROUTE = WS_X1B + 64 * MiB;
constexpr size_t RT_RSTD2 = WS_ROUTE;
constexpr size_t RT_TOPI = RT_RSTD2 + 128 * 1024;
constexpr size_t RT_TOPW = RT_TOPI + 512 * 1024;
constexpr size_t RT_CNT = RT_TOPW + 512 * 1024;
constexpr size_t RT_META = RT_CNT + 32 * 1024;
constexpr size_t RT_ROWTOK = RT_META + 4096;
constexpr size_t RT_ROWDST = RT_ROWTOK + 576 * 1024;
constexpr size_t RT_ROWW = RT_ROWDST + 576 * 1024;
static_assert((size_t)RMAX * 4 <= 576 * 1024 && RT_ROWW + 576 * 1024 <= WS_ROUTE + 4 * MiB, "route map");
constexpr size_t WS_EARLY = WS_ROUTE + 4 * MiB;
constexpr size_t WS_WIN = WS_EARLY;
constexpr size_t WS_ROPE = WS_WIN + 10 * MiB;
constexpr size_t WS_POW = WS_ROPE + 4 * MiB;

constexpr size_t WS_KT = WS_POW + 3 * MiB;
constexpr size_t WS_BF = WS_KT + 5 * MiB;
constexpr size_t WS_WSM = WS_BF + 1 * MiB;
constexpr size_t WS_WGLU = WS_WSM, WS_WA = WS_WSM + MiB / 2, WS_WS = WS_WSM + 1 * MiB, WS_WO = WS_WSM + 2 * MiB;
constexpr size_t WS_BT1 = WS_WSM + 4 * MiB;
constexpr size_t WS_E = WS_BT1 + 16 * MiB;
constexpr size_t WS_Z = WS_BT1;
constexpr size_t WS_BT2 = WS_E + 16 * MiB;
constexpr size_t WS_XB = WS_BT2 + 80 * MiB;
constexpr size_t WS_MIXED = WS_XB;
constexpr size_t WS_AO = WS_XB;
constexpr size_t WS_RSTD1 = WS_XB + 64 * MiB;
constexpr size_t WS_Q = WS_RSTD1 + 1 * MiB;
constexpr size_t WS_K = WS_Q + 48 * MiB;
constexpr size_t WS_V = WS_K + 48 * MiB;
constexpr size_t WS_T1 = WS_Q;
constexpr size_t WS_GLU = WS_V;
constexpr size_t WS_UA = WS_V + 48 * MiB;
constexpr size_t WS_GATES = WS_UA + 40 * MiB;
constexpr size_t WS_O = WS_GATES + 128 * MiB;
constexpr size_t WS_LSE = WS_O + 48 * MiB;
constexpr size_t WS_EARLY_END = WS_LSE + 2 * MiB;
constexpr size_t WS_ACT = WS_EARLY;
constexpr size_t WS_Y4 = WS_ACT + 272 * MiB;
constexpr size_t WS_END = (WS_EARLY_END > WS_Y4 + 257 * MiB) ? WS_EARLY_END : (WS_Y4 + 257 * MiB);
static_assert((size_t)RMAX * 2048 <= 272 * MiB, "ACT size");
static_assert(WS_END <= 1024 * MiB, "d_ws map must fit 1 GiB");

constexpr int CW_TMO = 0, CW_BAR = 4096;

constexpr int RING_BYTES = 131072, LDSX_OFF = RING_BYTES, MISC_OFF = LDSX_OFF + 320, TPRE_OFF = LDSX_OFF + 1024, LDS_BYTES = 147456;

#define RLX_AGENT __ATOMIC_RELAXED, __HIP_MEMORY_SCOPE_AGENT
#define LDS_WAIT() asm volatile("s_waitcnt lgkmcnt(0)" ::: "memory")
#define VM_WAIT() asm volatile("s_waitcnt vmcnt(0)" ::: "memory")
__device__ __forceinline__ unsigned f2bf(float f) { unsigned u = __builtin_bit_cast(unsigned, f); return (u + 0x7fffu + ((u >> 16) & 1u)) >> 16; }
__device__ __forceinline__ unsigned pk2(float lo, float hi) { f32x2 v = {lo, hi}; bf16x2_t b = __builtin_convertvector(v, bf16x2_t); return __builtin_bit_cast(unsigned, b); }
__device__ __forceinline__ unsigned pk4_fp8(float a, float b, float c, float d) { unsigned w = 0u; w = __builtin_amdgcn_cvt_pk_fp8_f32(a, b, w, false); w = __builtin_amdgcn_cvt_pk_fp8_f32(c, d, w, true); return w; }
__device__ __forceinline__ float bflo(unsigned w) { return __builtin_bit_cast(float, w << 16); }
__device__ __forceinline__ float bfhi(unsigned w) { return __builtin_bit_cast(float, w & 0xffff0000u); }
__device__ __forceinline__ float bf2f(bf16 b) { return __builtin_bit_cast(float, (unsigned)b << 16); }
__device__ __forceinline__ float sigmoidf_(float x) { return 1.0f / (1.0f + __expf(-x)); }
__device__ __forceinline__ float gelu_tanh(float x) { const float u = 0.7978845608028654f * (x + 0.044715f * x * x * x); return x * sigmoidf_(2.0f * u); }
__device__ __forceinline__ float wave_sum(float v) {
#pragma unroll
    for (int o = 1; o < 64; o <<= 1) v += __shfl_xor(v, o);
    return v;
}

namespace pg8 {
constexpr int BM = 256, BK = 64, HALF = 128, HTB = HALF * BK * 2, STAGE_BYTES = 8 * HTB;
__host__ __device__ __forceinline__ int lds_byte(int r, int c) { const int st = (r >> 4) * 2 + (c >> 5), rr = r & 15, cc = c & 31, ob = rr * 64 + cc * 2; return st * 1024 + (ob ^ (((ob >> 9) & 1) << 5)); }
__host__ __device__ __forceinline__ void stage_rc(int b, int& R, int& C) { const int st = b / 1024, sb = b % 1024, swz = sb ^ (((sb >> 9) & 1) << 5); R = (st >> 1) * 16 + swz / 64; C = (st & 1) * 32 + (swz % 64) / 2; }
__host__ __device__ __forceinline__ int perm32(int rho) { const int n = rho >> 4, i = rho & 15; return 8 * (i >> 2) + 4 * n + (i & 3); }

struct Unit { int pm, pn, e, row0; };
typedef int v4i_t __attribute__((ext_vector_type(4)));
typedef int v8i_t __attribute__((ext_vector_type(8)));
__device__ __forceinline__ v8i_t cat8(bf16x8 a, bf16x8 b) { const v4i_t x = __builtin_bit_cast(v4i_t, a), y = __builtin_bit_cast(v4i_t, b); return __builtin_shufflevector(x, y, 0, 1, 2, 3, 4, 5, 6, 7); }

__device__ __forceinline__ const char* sgpr_ptr(const char* p) { const unsigned long long v = (unsigned long long)p;
    return (const char*)(((unsigned long long)(unsigned)__builtin_amdgcn_readfirstlane((int)(v >> 32)) << 32) | (unsigned long long)(unsigned)__builtin_amdgcn_readfirstlane((int)(unsigned)v)); }
__device__ __forceinline__ bool static_order(int nM, int nN, int G, int c, int i, int& pm, int& pn) {
    const int nwg = nM * nN; const long L = (long)i * G + c; if (L >= nwg) return false;
    int wgid = (int)L; { const int q = nwg / 8, r = nwg % 8, xcd = wgid % 8, off = wgid / 8; wgid = (xcd < r ? xcd * (q + 1) : r * (q + 1) + (xcd - r) * q) + off; }
    const int nig = 8 * nN, gid = wgid / nig, fm = gid * 8, gsz = (nM - fm) < 8 ? (nM - fm) : 8;
    pm = fm + ((wgid % nig) % gsz); pn = (wgid % nig) / gsz; return true;
}

template <class P>
__device__ __forceinline__ void gemm_phase(LAS unsigned char* lds, const P& p) {
    const int tid = threadIdx.x, wid = __builtin_amdgcn_readfirstlane(tid >> 6), lane = tid & 63, wr = wid >> 2, wc = wid & 3, fr = lane & 15, fq = lane >> 4;
    const int K = p.K, KB = P::FP8 ? K : 2 * K  , nt = KB / 128;
    unsigned voffB[2], vA0[2], vA1[2];
#define PG8_AVOFF(u) do { int R0, C0, R1, C1; stage_rc(tid * 16, R0, C0); stage_rc(tid * 16 + 8192, R1, C1); p.a_voff(u, R0, R1, C0, C1, vA0, vA1); } while (0)
    { int R0, C0, R1, C1; stage_rc(tid * 16, R0, C0); stage_rc(tid * 16 + 8192, R1, C1); const int Rb0 = P::PERM ? ((R0 & ~31) + perm32(R0 & 31)) : R0, Rb1 = P::PERM ? ((R1 & ~31) + perm32(R1 & 31)) : R1;
      voffB[0] = (unsigned)(Rb0 * KB + C0 * 2); voffB[1] = (unsigned)(Rb1 * KB + C1 * 2); }
    const unsigned kstep = 128u;
    const unsigned hstepB = (unsigned)(HALF * KB);
    const __amdgpu_buffer_rsrc_t rsrc = __builtin_amdgcn_make_buffer_rsrc((void*)p.wsbase, 0, 0x7fffffff, 0x00020000);
    const unsigned ldsw = (unsigned)wid * 1024u;
    const int aoff = lds_byte(wr * 64 + fr, fq * 8), boff = lds_byte(wc * 32 + fr, fq * 8);
#define PG8_SA(b, h) (((b) * 2 + (h)) * HTB)
#define PG8_SB(b, h) ((4 + (b) * 2 + (h)) * HTB)
#define PG8_STAGE(bufoff, soff, voff) do { _Pragma("unroll") for (int _i = 0; _i < 2; ++_i) \
        __builtin_amdgcn_raw_ptr_buffer_load_lds(rsrc, (LAS void*)(lds + (bufoff) + ldsw + _i * 8192), 16, (int)(voff)[_i], (int)(soff), 0, 0); } while (0)
#define PG8_LDA(dst, b, h) do { _Pragma("unroll") for (int m = 0; m < 4; ++m) _Pragma("unroll") for (int k = 0; k < 2; ++k) dst[m][k] = *(const LAS bf16x8*)(lds + PG8_SA(b, h) + aoff + m * 2048 + k * 1024); } while (0)
#define PG8_LDB(dst, b, h) do { _Pragma("unroll") for (int n = 0; n < 2; ++n) _Pragma("unroll") for (int k = 0; k < 2; ++k) dst[n][k] = *(const LAS bf16x8*)(lds + PG8_SB(b, h) + boff + n * 2048 + k * 1024); } while (0)
#define PG8_MMA(ai, bj, At, Bt) do { __builtin_amdgcn_s_setprio(1); _Pragma("unroll") for (int m = 0; m < 4; ++m) _Pragma("unroll") for (int n = 0; n < 2; ++n) { \
        if constexpr (P::FP8) acc[ai][bj][m][n] = __builtin_amdgcn_mfma_scale_f32_16x16x128_f8f6f4(cat8(Bt[n][0], Bt[n][1]), cat8(At[m][0], At[m][1]), acc[ai][bj][m][n], 0, 0, 0, 0x7F7F7F7F, 0, 0x7F7F7F7F); \
        else { _Pragma("unroll") for (int k = 0; k < 2; ++k) acc[ai][bj][m][n] = __builtin_amdgcn_mfma_f32_16x16x32_bf16(Bt[n][k], At[m][k], acc[ai][bj][m][n], 0, 0, 0); } } \
        __builtin_amdgcn_s_setprio(0); } while (0)
#define PG8_WAIT_V(n) asm volatile("s_waitcnt vmcnt(" #n ")" ::: "memory")
#define PG8_WAIT_L(n) asm volatile("s_waitcnt lgkmcnt(" #n ")" ::: "memory")
#define PG8_BAR __builtin_amdgcn_s_barrier()
#define PG8_SCHED __builtin_amdgcn_sched_barrier(0)
    Unit cur, nxt; int ui = 0;
    if (!p.next(0, cur)) return;
    f32x4 acc[2][2][4][2];
#pragma unroll
    for (int a = 0; a < 2; ++a)
#pragma unroll
        for (int b = 0; b < 2; ++b)
#pragma unroll
            for (int m = 0; m < 4; ++m)
#pragma unroll
                for (int n = 0; n < 2; ++n) acc[a][b][m][n] = (f32x4){0.f, 0.f, 0.f, 0.f};
    bf16x8 At[4][2], B0[2][2], B1[2][2];
    unsigned cA = p.a_off(cur), cB = p.b_off(cur);
    PG8_AVOFF(cur);
    PG8_STAGE(PG8_SB(0, 0), cB, voffB); PG8_STAGE(PG8_SB(0, 1), cB + hstepB, voffB); PG8_STAGE(PG8_SA(0, 0), cA, vA0); PG8_STAGE(PG8_SA(0, 1), cA, vA1);
    if (wr == 1) PG8_BAR;
    PG8_WAIT_V(2); PG8_BAR;
    PG8_STAGE(PG8_SB(1, 0), cB + kstep, voffB); PG8_STAGE(PG8_SA(1, 0), cA + kstep, vA0); PG8_STAGE(PG8_SB(1, 1), cB + hstepB + kstep, voffB);
    PG8_WAIT_V(6); PG8_BAR;
    for (;;) {
        const bool has_next = p.next(ui + 1, nxt);
        const unsigned nA = has_next ? p.a_off(nxt) : cA, nB = has_next ? p.b_off(nxt) : cB;
        for (int t = 0; t < nt; t += 2) {
            const bool last = (t == nt - 2);
            const unsigned a1 = cA + (unsigned)(t + 1) * kstep;
            const unsigned a2 = last ? nA : cA + (unsigned)(t + 2) * kstep, b2 = last ? nB : cB + (unsigned)(t + 2) * kstep;
            const unsigned a3 = a2 + kstep, b3 = b2 + kstep;
            PG8_LDB(B0, 0, 0); PG8_LDB(B1, 0, 1); PG8_SCHED; PG8_LDA(At, 0, 0); PG8_STAGE(PG8_SA(1, 1), a1, vA1);
            if constexpr (P::AVAR) { if (last && has_next) PG8_AVOFF(nxt); }
            PG8_WAIT_V(8); PG8_WAIT_L(0); PG8_BAR; PG8_MMA(0, 0, At, B0); PG8_MMA(0, 1, At, B1); PG8_BAR; PG8_SCHED;
            PG8_LDA(At, 0, 1); PG8_STAGE(PG8_SB(0, 0), b2, voffB); PG8_STAGE(PG8_SB(0, 1), b2 + hstepB, voffB); PG8_STAGE(PG8_SA(0, 0), a2, vA0);
            PG8_WAIT_V(8); PG8_WAIT_L(0); PG8_BAR; PG8_MMA(1, 0, At, B0); PG8_MMA(1, 1, At, B1); PG8_BAR; PG8_SCHED;
            PG8_LDB(B0, 1, 0); PG8_LDB(B1, 1, 1); PG8_SCHED; PG8_LDA(At, 1, 0); PG8_STAGE(PG8_SA(0, 1), a2, vA1);
            PG8_WAIT_V(8); PG8_WAIT_L(0); PG8_BAR; PG8_MMA(0, 0, At, B0); PG8_MMA(0, 1, At, B1); PG8_BAR; PG8_SCHED;
            PG8_LDA(At, 1, 1); PG8_STAGE(PG8_SB(1, 0), b3, voffB); PG8_STAGE(PG8_SB(1, 1), b3 + hstepB, voffB); PG8_STAGE(PG8_SA(1, 0), a3, vA0);
            PG8_WAIT_V(8); PG8_WAIT_L(0); PG8_BAR; PG8_MMA(1, 0, At, B0); PG8_MMA(1, 1, At, B1); PG8_BAR; PG8_SCHED;
        }
        if (wr == 0) PG8_BAR;
        p.epi(acc, cur, wr, wc, fr, fq);
        if (!has_next) break;
#pragma unroll
        for (int a = 0; a < 2; ++a)
#pragma unroll
            for (int b = 0; b < 2; ++b)
#pragma unroll
                for (int m = 0; m < 4; ++m)
#pragma unroll
                    for (int n = 0; n < 2; ++n) acc[a][b][m][n] = (f32x4){0.f, 0.f, 0.f, 0.f};
        cur = nxt; cA = nA; cB = nB; ++ui;
        if (wr == 1) PG8_BAR;
    }
    PG8_WAIT_V(0);
    PG8_BAR;
#undef PG8_AVOFF
#undef PG8_SA
#undef PG8_SB
#undef PG8_STAGE
#undef PG8_LDA
#undef PG8_LDB
#undef PG8_MMA
#undef PG8_WAIT_V
#undef PG8_WAIT_L
#undef PG8_BAR
#undef PG8_SCHED
}
}
using pg8::Unit;
typedef f32x4 AccT[2][2][4][2];

struct DenseA {
    unsigned A; int lda;
    __device__ __forceinline__ unsigned base(int pm) const { return A + (unsigned)(pm * 256 * lda * 2); }
    __device__ __forceinline__ void voff(int R0, int R1, int C0, int C1, unsigned* v0, unsigned* v1) const {
        v0[0] = (unsigned)(R0 * lda + C0) * 2u; v0[1] = (unsigned)(R1 * lda + C1) * 2u; v1[0] = v0[0] + (unsigned)(128 * lda * 2); v1[1] = v0[1] + (unsigned)(128 * lda * 2); }
};
__device__ __forceinline__ u32x4 pack8(const f32x4& a, const f32x4& b) { u32x4 w; w.x = pk2(a[0], a[1]); w.y = pk2(a[2], a[3]); w.z = pk2(b[0], b[1]); w.w = pk2(b[2], b[3]); return w; }
__device__ __forceinline__ void unpack8(const u32x4& w, f32x4& a, f32x4& b) { a = (f32x4){bflo(w.x), bfhi(w.x), bflo(w.y), bfhi(w.y)}; b = (f32x4){bflo(w.z), bfhi(w.z), bflo(w.w), bfhi(w.w)}; }
#define EPI_FENCE() asm volatile("" ::: "memory")

struct PolG1 {
    static constexpr bool PERM = true; static constexpr bool FP8 = false; static constexpr bool AVAR = true;
    int K, G, c; const unsigned char* wsbase;
    const float* rstd1; const float* qn; const float* kn; const float* rope;
    bf16 *Q, *Kb, *V, *UA, *GT;
    __device__ __forceinline__ bool next(int i, Unit& u) const { u.e = 0; u.row0 = 0;
#if defined(REPEAT_MASK) && (REPEAT_MASK & 2)
        const int L = i * G + c; if (L >= 2 * 2432) return false; const int L2 = L % 2432; return pg8::static_order(128, 19, G, L2 % G, L2 / G, u.pm, u.pn);
#else
        return pg8::static_order(128, 19, G, c, i, u.pm, u.pn);
#endif
    }
    __device__ __forceinline__ int tok0(const Unit& u, int& sh) const {
        if (u.pn >= 9) { sh = 0; return u.pm * 256; }
        sh = 2 * (u.pn % 3); const int pr0 = u.pm * 256, b = pr0 >> 14, q = pr0 & 16383, rr = q >> (14 - sh), i0 = q & ((16384 >> sh) - 1);
        return (b << 14) + (i0 << sh) + rr;
    }
    __device__ __forceinline__ unsigned a_off(const Unit& u) const { int sh; const int t0 = tok0(u, sh); return (unsigned)WS_XB + (unsigned)t0 * 2048u; }
    __device__ __forceinline__ void a_voff(const Unit& u, int R0, int R1, int C0, int C1, unsigned* v0, unsigned* v1) const {
        int sh; (void)tok0(u, sh); const unsigned rs = 2048u << sh;
        v0[0] = (unsigned)R0 * rs + (unsigned)C0 * 2u; v0[1] = (unsigned)R1 * rs + (unsigned)C1 * 2u; v1[0] = v0[0] + 128u * rs; v1[1] = v0[1] + 128u * rs; }
    __device__ __forceinline__ unsigned b_off(const Unit& u) const { return (unsigned)WS_WIN + (unsigned)u.pn * (256u * 1024u * 2u); }
    __device__ __forceinline__ void epi(AccT& acc, const Unit& u, int wr, int wc, int fr, int fq) const {
        int sh; const int t0 = tok0(u, sh);
        if (u.pn < 6) {
            const int g = u.pn % 3, head = 4 * g + wc; const bool isq = u.pn < 3;
            const float* gain = (isq ? qn : kn) + head * 64; const float sc = isq ? QSCALE : 1.0f;
            bf16* dst = (isq ? Q : Kb) + (size_t)head * T * 64;
            f32x4 gv[2][2];
#pragma unroll
            for (int bj = 0; bj < 2; ++bj)
#pragma unroll
                for (int n = 0; n < 2; ++n) gv[bj][n] = *(const f32x4*)(gain + 32 * bj + 8 * fq + 4 * n);
#pragma unroll
            for (int ai = 0; ai < 2; ++ai)
#pragma unroll
                for (int m = 0; m < 4; ++m) {
                    const int r = 128 * ai + 64 * wr + 16 * m + fr, token = t0 + (r << sh), prow = u.pm * 256 + r; const float rs = rstd1[token];
                    f32x4 x[2][2]; float ss = 0.f;
#pragma unroll
                    for (int bj = 0; bj < 2; ++bj)
#pragma unroll
                        for (int n = 0; n < 2; ++n) { x[bj][n] = acc[ai][bj][m][n] * rs; const f32x4 q2 = x[bj][n] * x[bj][n]; ss += (q2[0] + q2[1]) + (q2[2] + q2[3]); }
                    ss += __shfl_xor(ss, 16); ss += __shfl_xor(ss, 32);
                    const float rn = rsqrtf(ss * (1.0f / 64.0f) + NORM_EPS) * sc;
                    const int pos = token & 16383; const f32x4* rp = (const f32x4*)(rope + ((size_t)pos * 32 + 8 * fq) * 2);
                    f32x4 olo[2], ohi[2];
#pragma unroll
                    for (int n = 0; n < 2; ++n) {
                        const f32x4 cs0 = rp[2 * n], cs1 = rp[2 * n + 1];
                        const f32x4 cv = {cs0[0], cs0[2], cs1[0], cs1[2]}, sv = {cs0[1], cs0[3], cs1[1], cs1[3]};
                        const f32x4 lo = x[0][n] * gv[0][n] * rn, hi = x[1][n] * gv[1][n] * rn;
                        olo[n] = lo * cv - hi * sv; ohi[n] = hi * cv + lo * sv;
                    }
                    bf16* rowp = dst + (size_t)prow * 64 + 8 * fq;
                    *(u32x4*)rowp = pack8(olo[0], olo[1]); *(u32x4*)(rowp + 32) = pack8(ohi[0], ohi[1]);
                    if (m & 1) EPI_FENCE();
                }
        } else if (u.pn < 9) {
            const int g = u.pn % 3, head = 4 * g + wc; bf16* dst = V + (size_t)head * T * 64;
#pragma unroll
            for (int ai = 0; ai < 2; ++ai)
#pragma unroll
                for (int m = 0; m < 4; ++m) {
                    const int r = 128 * ai + 64 * wr + 16 * m + fr, token = t0 + (r << sh), prow = u.pm * 256 + r; const float rs = rstd1[token];
                    bf16* rowp = dst + (size_t)prow * 64 + 8 * fq;
#pragma unroll
                    for (int bj = 0; bj < 2; ++bj) *(u32x4*)(rowp + 32 * bj) = pack8(acc[ai][bj][m][0] * rs, acc[ai][bj][m][1] * rs);
                }
        } else if (u.pn < 11) {
#pragma unroll
            for (int ai = 0; ai < 2; ++ai)
#pragma unroll
                for (int m = 0; m < 4; ++m) {
                    const int r = 128 * ai + 64 * wr + 16 * m + fr, token = t0 + r; const float rs = rstd1[token];
#pragma unroll
                    for (int bj = 0; bj < 2; ++bj) { const int col0 = 256 * (u.pn - 9) + 128 * bj + 32 * wc + 8 * fq, gq = col0 >> 4, ch0 = col0 & 15;
                        *(u32x4*)(UA + ((size_t)(gq * NCH + (token >> 6)) * KA2 + (token & 63) * 16 + ch0)) = pack8(acc[ai][bj][m][0] * rs, acc[ai][bj][m][1] * rs); }
                }
        } else {
#pragma unroll
            for (int ai = 0; ai < 2; ++ai)
#pragma unroll
                for (int m = 0; m < 4; ++m) {
                    const int r = 128 * ai + 64 * wr + 16 * m + fr, token = t0 + r; const float rs = rstd1[token];
#pragma unroll
                    for (int bj = 0; bj < 2; ++bj) { const int col0 = 256 * (u.pn - 11) + 128 * bj + 32 * wc + 8 * fq; f32x4 a = acc[ai][bj][m][0] * rs, b = acc[ai][bj][m][1] * rs;
#pragma unroll
                        for (int i = 0; i < 4; ++i) { a[i] = sigmoidf_(a[i]); b[i] = sigmoidf_(b[i]); }
                        *(u32x4*)(GT + (size_t)token * 2048 + col0) = pack8(a, b); }
                }
        }
    }
};

struct PolS5a {
    static constexpr bool PERM = false; static constexpr bool FP8 = false; static constexpr bool AVAR = false;
    int K, G, c; const unsigned char* wsbase; float* E;
    __device__ __forceinline__ bool next(int i, Unit& u) const { int L = i * G + c; if (L >= 64) { if (!((REPEAT_MASK >> 12) & 1) || i != 1 || c >= 64) return false; L = c; } u.e = L >> 1; u.pm = L & 1; u.pn = 0; u.row0 = 0; return true; }
    __device__ __forceinline__ unsigned a_off(const Unit& u) const { return (unsigned)WS_UA + (unsigned)(u.e * NCH + u.pm * 256) * (KA2 * 2u); }
    __device__ __forceinline__ void a_voff(const Unit&, int R0, int R1, int C0, int C1, unsigned* v0, unsigned* v1) const { DenseA d{0u, KA2}; d.voff(R0, R1, C0, C1, v0, v1); }
    __device__ __forceinline__ unsigned b_off(const Unit& u) const { return (unsigned)WS_BT1 + (unsigned)u.e * (256u * 1024u * 2u); }
    __device__ __forceinline__ void epi(AccT& acc, const Unit& u, int wr, int wc, int fr, int fq) const {
#pragma unroll
        for (int ai = 0; ai < 2; ++ai)
#pragma unroll
            for (int m = 0; m < 4; ++m) { const int r = 128 * ai + 64 * wr + 16 * m + fr; float* rowp = E + (size_t)(u.e * NCH + u.pm * 256 + r) * 256 + 32 * wc + 4 * fq;
#pragma unroll
                for (int bj = 0; bj < 2; ++bj)
#pragma unroll
                    for (int n = 0; n < 2; ++n) *(f32x4*)(rowp + 128 * bj + 16 * n) = acc[ai][bj][m][n]; }
    }
};
struct PolS5b {
    static constexpr bool PERM = true; static constexpr bool FP8 = false; static constexpr bool AVAR = false;
    int K, G, vcu; const unsigned char* wsbase; bf16* Z;
    __device__ __forceinline__ bool next(int i, Unit& u) const { int L = i * G + vcu; if (L >= (((REPEAT_MASK >> 4) & 1) ? 512 : 256)) return false; L &= 255; u.e = L >> 3; u.pm = (L >> 2) & 1; u.pn = L & 3; u.row0 = 0; return true; }
    __device__ __forceinline__ unsigned a_off(const Unit& u) const { return (unsigned)WS_UA + (unsigned)(u.e * NCH + u.pm * 256) * (KA2 * 2u); }
    __device__ __forceinline__ void a_voff(const Unit&, int R0, int R1, int C0, int C1, unsigned* v0, unsigned* v1) const { DenseA d{0u, KA2}; d.voff(R0, R1, C0, C1, v0, v1); }
    __device__ __forceinline__ unsigned b_off(const Unit& u) const { return (unsigned)WS_BT2 + (unsigned)(u.e * 1024 + u.pn * 256) * (KA2 * 2u); }
    __device__ __forceinline__ void epi(AccT& acc, const Unit& u, int wr, int wc, int fr, int fq) const {
#pragma unroll
        for (int ai = 0; ai < 2; ++ai)
#pragma unroll
            for (int m = 0; m < 4; ++m) { const int r = 128 * ai + 64 * wr + 16 * m + fr, chunk = u.pm * 256 + r;
#pragma unroll
                for (int bj = 0; bj < 2; ++bj) { const int tl = 16 * u.pn + 8 * bj + 2 * wc + (fq >> 1), c0 = 8 * (fq & 1); f32x4 a = acc[ai][bj][m][0], b = acc[ai][bj][m][1];
#pragma unroll
                    for (int i = 0; i < 4; ++i) { a[i] = gelu_tanh(a[i]); b[i] = gelu_tanh(b[i]); }
                    *(u32x4*)(Z + (size_t)(chunk * 64 + tl) * SSMW + u.e * 16 + c0) = pack8(a, b); } }
    }
};
template <int KIND> struct PolDense {
    static constexpr bool PERM = (KIND != 3); static constexpr bool FP8 = false; static constexpr bool AVAR = false;
    int K, G, c, nN; const unsigned char* wsbase; DenseA A; unsigned Bt;
    const bf16* in0; const bf16* in1; const float* fin; const float* bias; bf16* o16; float* o32;
    __device__ __forceinline__ bool next(int i, Unit& u) const { u.e = 0; u.row0 = 0; return pg8::static_order(128, nN, G, c, i, u.pm, u.pn); }
    __device__ __forceinline__ unsigned a_off(const Unit& u) const { return A.base(u.pm); }
    __device__ __forceinline__ void a_voff(const Unit&, int R0, int R1, int C0, int C1, unsigned* v0, unsigned* v1) const { A.voff(R0, R1, C0, C1, v0, v1); }
    __device__ __forceinline__ unsigned b_off(const Unit& u) const { return Bt + (unsigned)(u.pn * 256 * K * 2); }
    __device__ __forceinline__ void epi(AccT& acc, const Unit& u, int wr, int wc, int fr, int fq) const {
#pragma unroll
        for (int ai = 0; ai < 2; ++ai)
#pragma unroll
            for (int m = 0; m < 4; ++m) { const int row = u.pm * 256 + 128 * ai + 64 * wr + 16 * m + fr;
#pragma unroll
                for (int bj = 0; bj < 2; ++bj) {
                    if constexpr (KIND == 0) {
                        const int col = u.pn * 256 + 128 * bj + 32 * wc + 8 * fq; f32x4 za, zb; unpack8(*(const u32x4*)(in0 + (size_t)row * SSMW + col), za, zb);
                        f32x4 a = acc[ai][bj][m][0] + *(const f32x4*)(bias + col), b = acc[ai][bj][m][1] + *(const f32x4*)(bias + col + 4);
#pragma unroll
                        for (int i = 0; i < 4; ++i) { a[i] = za[i] * sigmoidf_(a[i]); b[i] = zb[i] * sigmoidf_(b[i]); }
                        *(u32x4*)(o16 + (size_t)row * SSMW + col) = pack8(a, b);
                    } else if constexpr (KIND == 1) {
                        const int col = u.pn * 256 + 128 * bj + 32 * wc + 8 * fq; f32x4 ga, gb; unpack8(*(const u32x4*)(in0 + (size_t)row * 2048 + col), ga, gb);
                        *(u32x4*)(o16 + (size_t)row * DM + col) = pack8(acc[ai][bj][m][0] * ga, acc[ai][bj][m][1] * gb);
                    } else if constexpr (KIND == 2) {
                        const int col = u.pn * 256 + 128 * bj + 32 * wc + 8 * fq; f32x4 ga, gb, ta, tb; unpack8(*(const u32x4*)(in0 + (size_t)row * 2048 + 1024 + col), ga, gb); unpack8(*(const u32x4*)(in1 + (size_t)row * DM + col), ta, tb);
                        *(u32x4*)(o16 + (size_t)row * DM + col) = pack8(ta + acc[ai][bj][m][0] * ga, tb + acc[ai][bj][m][1] * gb);
                    } else {
#pragma unroll
                        for (int n = 0; n < 2; ++n) { const int col = u.pn * 256 + 128 * bj + 32 * wc + 16 * n + 4 * fq; const f32x4 v = *(const f32x4*)(fin + (size_t)row * DM + col) + acc[ai][bj][m][n];
                            *(f32x4*)(o32 + (size_t)row * DM + col) = v;
                            if constexpr (MOE_FP8 != 0) *(unsigned*)((unsigned char*)o16 + (size_t)row * DM + col) = pk4_fp8(v[0], v[1], v[2], v[3]);
                            else { u32x2 w; w.x = pk2(v[0], v[1]); w.y = pk2(v[2], v[3]); *(u32x2*)(o16 + (size_t)row * DM + col) = w; } }
                    }
                }
                if (m & 1) EPI_FENCE(); }
    }
};
__device__ __forceinline__ bool moe_next(const LAS int* tp, int npn_log, int G, int vcu, int i, Unit& u) {
    const int L = i * G + vcu, tiles = __builtin_amdgcn_readfirstlane(tp[32]); if (L >= (tiles << npn_log)) return false;
    const int tile = L >> npn_log; u.pn = L & ((1 << npn_log) - 1); int e = 0;
#pragma unroll 1
    for (int k = 1; k < 32; ++k) e += (tile >= tp[k]) ? 1 : 0;
    e = __builtin_amdgcn_readfirstlane(e); u.e = e; u.pm = __builtin_amdgcn_readfirstlane(tile - tp[e]); u.row0 = tile * 256; return true;
}
constexpr float W8SCALE = 256.0f, W8INV = 1.0f / 256.0f;
struct PolMoeGU {
    static constexpr bool PERM = true; static constexpr bool AVAR = true; static constexpr bool FP8 = (MOE_FP8 != 0); static constexpr int EB = FP8 ? 1 : 2;
    int K, G, vcu; const unsigned char* wsbase; const LAS int* tp; const int* rowtok; const float* rstd2; const float* bgu; unsigned char* ACT;
    __device__ __forceinline__ bool next(int i, Unit& u) const { return moe_next(tp, 3, G, vcu, i, u); }
    __device__ __forceinline__ unsigned a_off(const Unit&) const { return (unsigned)WS_X1B; }
    __device__ __forceinline__ void a_voff(const Unit& u, int R0, int R1, int C0, int C1, unsigned* v0, unsigned* v1) const {
        const int* rt = rowtok + u.row0; const unsigned pitch = 1024u * EB;
        v0[0] = (unsigned)rt[R0] * pitch + (unsigned)C0 * 2u; v0[1] = (unsigned)rt[R1] * pitch + (unsigned)C1 * 2u;
        v1[0] = (unsigned)rt[128 + R0] * pitch + (unsigned)C0 * 2u; v1[1] = (unsigned)rt[128 + R1] * pitch + (unsigned)C1 * 2u; }
    __device__ __forceinline__ unsigned b_off(const Unit& u) const { return (unsigned)WS_WGU + (unsigned)(u.e * 2048 + u.pn * 256) * (1024u * EB); }
    __device__ __forceinline__ void epi(AccT& acc, const Unit& u, int wr, int wc, int fr, int fq) const {
        const int colg = u.pn * 128 + 32 * wc + 8 * fq; const float* bg = bgu + (size_t)u.e * 2048 + colg;
        const f32x4 bg0 = *(const f32x4*)bg, bg1 = *(const f32x4*)(bg + 4), bu0 = *(const f32x4*)(bg + 1024), bu1 = *(const f32x4*)(bg + 1028);
#pragma unroll
        for (int ai = 0; ai < 2; ++ai)
#pragma unroll
            for (int m = 0; m < 4; ++m) { const int row = u.row0 + 128 * ai + 64 * wr + 16 * m + fr; const float rs = rstd2[rowtok[row]] * (FP8 ? W8INV : 1.0f);
                f32x4 ga = acc[ai][0][m][0] * rs + bg0, gb = acc[ai][0][m][1] * rs + bg1, ua = acc[ai][1][m][0] * rs + bu0, ub = acc[ai][1][m][1] * rs + bu1;
#pragma unroll
                for (int i = 0; i < 4; ++i) { float g1 = fminf(ga[i], 7.0f), u1 = fminf(fmaxf(ua[i], -7.0f), 7.0f); ga[i] = g1 * sigmoidf_(1.702f * g1) * (u1 + 1.0f);
                                              float g2 = fminf(gb[i], 7.0f), u2 = fminf(fmaxf(ub[i], -7.0f), 7.0f); gb[i] = g2 * sigmoidf_(1.702f * g2) * (u2 + 1.0f); }
                if constexpr (FP8) { u32x2 w; w.x = pk4_fp8(ga[0], ga[1], ga[2], ga[3]); w.y = pk4_fp8(gb[0], gb[1], gb[2], gb[3]); *(u32x2*)(ACT + (size_t)row * 1024 + colg) = w; }
                else *(u32x4*)((bf16*)ACT + (size_t)row * 1024 + colg) = pack8(ga, gb);
                if (m & 1) EPI_FENCE(); }
    }
};
struct PolMoeDN {
    static constexpr bool PERM = true; static constexpr bool AVAR = true; static constexpr bool FP8 = (MOE_FP8 != 0); static constexpr int EB = FP8 ? 1 : 2;
    int K, G, vcu; const unsigned char* wsbase; const LAS int* tp; const int* rowdst; const float* roww; const float* bd; bf16* Y4;
    __device__ __forceinline__ bool next(int i, Unit& u) const { return moe_next(tp, 2, G, vcu, i, u); }
    __device__ __forceinline__ unsigned a_off(const Unit&) const { return (unsigned)WS_ACT; }
    __device__ __forceinline__ void a_voff(const Unit& u, int R0, int R1, int C0, int C1, unsigned* v0, unsigned* v1) const {
        const unsigned pitch = 1024u * EB; R0 += u.row0; R1 += u.row0; v0[0] = (unsigned)R0 * pitch + (unsigned)C0 * 2u; v0[1] = (unsigned)R1 * pitch + (unsigned)C1 * 2u; v1[0] = v0[0] + 128u * pitch; v1[1] = v0[1] + 128u * pitch; }
    __device__ __forceinline__ unsigned b_off(const Unit& u) const { return (unsigned)WS_WD + (unsigned)(u.e * 1024 + u.pn * 256) * (1024u * EB); }
    __device__ __forceinline__ void epi(AccT& acc, const Unit& u, int wr, int wc, int fr, int fq) const {
        const float sc = FP8 ? W8INV : 1.0f;
#pragma unroll
        for (int ai = 0; ai < 2; ++ai)
#pragma unroll
            for (int m = 0; m < 4; ++m) { const int row = u.row0 + 128 * ai + 64 * wr + 16 * m + fr; const int dst = rowdst[row]; const float w = roww[row];
#pragma unroll
                for (int bj = 0; bj < 2; ++bj) { const int col = u.pn * 256 + 128 * bj + 32 * wc + 8 * fq; const float* bb = bd + (size_t)u.e * 1024 + col;
                    *(u32x4*)(Y4 + (size_t)dst * 1024 + col) = pack8((acc[ai][bj][m][0] * sc + *(const f32x4*)bb) * w, (acc[ai][bj][m][1] * sc + *(const f32x4*)(bb + 4)) * w); }
                if (m & 1) EPI_FENCE(); }
    }
};

struct Args { const float* in[25]; float* out; unsigned char* ws; int ph_lo, ph_hi; };
enum { I_X = 0, I_NORM1, I_WIN, I_QN, I_KN, I_LRE, I_LIM, I_LDT, I_BRE, I_BIM, I_CRE, I_CIM, I_DSK, I_WGLU, I_BGLU, I_WA, I_WS, I_WO, I_NORM2, I_WR, I_BR, I_WGU, I_BGU, I_WD, I_BD };

__device__ __forceinline__ int tr_dstrow(int mode, int n) {
    if (mode == 1) { if (n >= 2304) return n; const int pn = n >> 8, np = n & 255, hh = np >> 6, dd = np & 63; return (pn << 8) + 128 * (dd >> 5) + 32 * hh + (dd & 31); }
    if (mode == 2) { if (n < 1024) return ((n >> 7) << 8) + (n & 127); const int u = n - 1024; return ((u >> 7) << 8) + 128 + (u & 127); }
    return n;
}
__device__ __forceinline__ void p0_transpose_item(const float* W, int K, int N, bf16* WT, int mode, const float* ksc, LAS unsigned* scr, int item, int lane) {
    const int nblk = N / 64, kb = item / nblk, nb = item % nblk, k0 = 64 * kb, n0 = 64 * nb, n4 = lane & 15, q = lane >> 4;
    f32x4 v[16];
#pragma unroll
    for (int i = 0; i < 8; ++i) { const float* src = W + (size_t)(k0 + 8 * i + 2 * q) * N + n0 + 4 * n4; v[2 * i] = *(const f32x4*)src; v[2 * i + 1] = *(const f32x4*)(src + N); }
#pragma unroll
    for (int i = 0; i < 8; ++i) { f32x4 a = v[2 * i], b = v[2 * i + 1]; if (ksc) { a = a * ksc[k0 + 8 * i + 2 * q]; b = b * ksc[k0 + 8 * i + 2 * q + 1]; }
        LAS unsigned* d = scr + (4 * i + q) * 65 + 4 * n4; d[0] = pk2(a[0], b[0]); d[1] = pk2(a[1], b[1]); d[2] = pk2(a[2], b[2]); d[3] = pk2(a[3], b[3]); }
    LDS_WAIT(); asm volatile("" ::: "memory");
    const int c8 = lane & 7;
#pragma unroll
    for (int j = 0; j < 8; ++j) { const int n = 8 * j + (lane >> 3); const LAS unsigned* s2 = scr + (4 * c8) * 65 + n;
        u32x4 o; o.x = s2[0]; o.y = s2[65]; o.z = s2[130]; o.w = s2[195];
        *(u32x4*)(WT + (size_t)tr_dstrow(mode, n0 + n) * K + k0 + 8 * c8) = o; }
    LDS_WAIT(); asm volatile("" ::: "memory");
}
__device__ __forceinline__ void p0_transpose_item8(const float* W, int K, int N, unsigned char* WT, int mode, const float* ksc, LAS unsigned* scr, int item, int lane) {
    const int nblk = N / 64, kb = item / nblk, nb = item % nblk, k0 = 64 * kb, n0 = 64 * nb, n4 = lane & 15, q = lane >> 4;
    f32x4 v[16];
#pragma unroll
    for (int i = 0; i < 4; ++i)
#pragma unroll
        for (int d = 0; d < 4; ++d) v[4 * i + d] = *(const f32x4*)(W + (size_t)(k0 + 16 * i + 4 * q + d) * N + n0 + 4 * n4);
#pragma unroll
    for (int i = 0; i < 4; ++i) { float sc[4];
#pragma unroll
        for (int d = 0; d < 4; ++d) sc[d] = ksc ? ksc[k0 + 16 * i + 4 * q + d] * W8SCALE : W8SCALE;
        LAS unsigned* dd = scr + (4 * i + q) * 65 + 4 * n4;
#pragma unroll
        for (int c = 0; c < 4; ++c) dd[c] = pk4_fp8(v[4 * i][c] * sc[0], v[4 * i + 1][c] * sc[1], v[4 * i + 2][c] * sc[2], v[4 * i + 3][c] * sc[3]); }
    LDS_WAIT(); asm volatile("" ::: "memory");
    const int c4 = lane & 3;
#pragma unroll
    for (int j = 0; j < 4; ++j) { const int n = 16 * j + (lane >> 2); const LAS unsigned* s2 = scr + (4 * c4) * 65 + n;
        u32x4 o; o.x = s2[0]; o.y = s2[65]; o.z = s2[130]; o.w = s2[195];
        *(u32x4*)(WT + (size_t)tr_dstrow(mode, n0 + n) * K + k0 + 16 * c4) = o; }
    LDS_WAIT(); asm volatile("" ::: "memory");
}
__device__ __forceinline__ void s5_mode(const Args& a, int g, int dir, int p, double& lr, double& li, double& dt) {
    const int gi = dir * NG + g; dt = exp((double)a.in[I_LDT][gi]); lr = (double)a.in[I_LRE][gi * NP + p]; li = (double)a.in[I_LIM][gi * NP + p];
}
__device__ __forceinline__ void p0_prologue(const Args& a, LAS unsigned char* lds, int tid, int lane, int wave, int vcu, int G) {
    unsigned char* ws = a.ws;
    const int gw = vcu * NWAVES + wave, NGW = G * NWAVES, gt = vcu * NTHREADS + tid, NT = G * NTHREADS;
    P0REP(0) {
        const int g = vcu >> 3, s = vcu & 7;
        LAS f32x2* Cc = (LAS f32x2*)lds;
        LAS f32x2* Bf = (LAS f32x2*)(lds + 16384);
        LAS f32x2* Pw = (LAS f32x2*)(lds + 32768);
        LAS f32x2* Fm = (LAS f32x2*)(lds + 32768 + 8192);
        if (vcu < 256) {
            for (int i = tid; i < 2048; i += NTHREADS) { const int dir = i >> 10, c = (i >> 6) & 15, p = i & 63; const int src = ((dir * NG + g) * GC + c) * NP + p; Cc[i] = (f32x2){a.in[I_CRE][src], a.in[I_CIM][src]}; }
            if (tid < 128) { const int dir = tid >> 6, p = tid & 63; double lr, li, dt; s5_mode(a, g, dir, p, lr, li, dt);
                const double mag = exp(lr * dt), ar = mag * cos(li * dt), ai = mag * sin(li * dt), nr = ar - 1.0, den = lr * lr + li * li;
                Fm[tid] = (f32x2){(float)((nr * lr + ai * li) / den), (float)((ai * lr - nr * li) / den)}; }
            for (int i = tid; i < 1024; i += NTHREADS) { const int k = i >> 6, p = i & 63, ts = 16 * s + k - 63, dir = ts >= 0 ? 0 : 1, e = ts >= 0 ? ts : -ts;
                double lr, li, dt; s5_mode(a, g, dir, p, lr, li, dt); const double mag = exp(lr * dt * e), ang = li * dt * e; Pw[i] = (f32x2){(float)(mag * cos(ang)), (float)(mag * sin(ang))}; }
            __syncthreads();
            for (int i = tid; i < 2048; i += NTHREADS) { const int dir = i >> 10, p = (i >> 4) & 63, cp = i & 15; const int src = ((dir * NG + g) * NP + p) * GC + cp;
                const float br = a.in[I_BRE][src], bi = a.in[I_BIM][src]; const f32x2 f = Fm[dir * 64 + p]; Bf[i] = (f32x2){f.x * br - f.y * bi, f.x * bi + f.y * br}; }
            __syncthreads();
            const int k = tid >> 5, c = (tid >> 1) & 15, hf = tid & 1, tp = 16 * s + k, ts = tp - 63;
            if (tp < 127) {
                float acc[8];
#pragma unroll
                for (int j = 0; j < 8; ++j) acc[j] = 0.f;
                for (int dir = 0; dir < 2; ++dir) {
                    if (ts > 0 && dir == 1) continue; if (ts < 0 && dir == 0) continue;
                    for (int p = 0; p < 64; ++p) { const f32x2 cc = Cc[(dir * 16 + c) * 64 + p]; f32x2 w = cc; if (ts != 0) { const f32x2 pw = Pw[k * 64 + p]; w = (f32x2){cc.x * pw.x - cc.y * pw.y, cc.x * pw.y + cc.y * pw.x}; }
#pragma unroll
                        for (int j = 0; j < 8; ++j) { const f32x2 b = Bf[(dir * 64 + p) * 16 + 8 * hf + j]; acc[j] += w.x * b.x - w.y * b.y; } }
                }
                if (ts == 0) {
#pragma unroll
                    for (int j = 0; j < 8; ++j) if (8 * hf + j == c) acc[j] += a.in[I_DSK][g * GC + c]; }
                float* kt = (float*)(ws + WS_KT) + ((size_t)(g * 127 + tp) * 16 + c) * 16 + 8 * hf;
                *(f32x4*)kt = (f32x4){acc[0], acc[1], acc[2], acc[3]}; *(f32x4*)(kt + 4) = (f32x4){acc[4], acc[5], acc[6], acc[7]};
            }
            __syncthreads();
        }
    }
    P0REP(1) {
        LAS unsigned* scr = (LAS unsigned*)(lds + wave * 16384);
        constexpr int I0 = 16 * 76, I1 = I0 + 8 * 8, I2 = I1 + 4 * 16, I3 = I2 + 8 * 16, I4 = I3 + 16 * 16, I5 = I4 + 32 * 16 * 32, I6 = I5 + 32 * 16 * 16;
        for (int it = gw; it < I6; it += NGW) {
            if (it < I0) p0_transpose_item(a.in[I_WIN], 1024, INW, (bf16*)(ws + WS_WIN), 1, a.in[I_NORM1], scr, it, lane);
            else if (it < I1) p0_transpose_item(a.in[I_WGLU], 512, 512, (bf16*)(ws + WS_WGLU), 0, nullptr, scr, it - I0, lane);
            else if (it < I2) p0_transpose_item(a.in[I_WA], 256, 1024, (bf16*)(ws + WS_WA), 0, nullptr, scr, it - I1, lane);
            else if (it < I3) p0_transpose_item(a.in[I_WS], 512, 1024, (bf16*)(ws + WS_WS), 0, nullptr, scr, it - I2, lane);
            else if (it < I4) p0_transpose_item(a.in[I_WO], 1024, 1024, (bf16*)(ws + WS_WO), 0, nullptr, scr, it - I3, lane);
            else if (it < I5) { const int r = it - I4, e = r >> 9;
                if (MOE_FP8) p0_transpose_item8(a.in[I_WGU] + (size_t)e * 1024 * 2048, 1024, 2048, ws + WS_WGU + (size_t)e * 2048 * 1024, 2, a.in[I_NORM2], scr, r & 511, lane);
                else p0_transpose_item(a.in[I_WGU] + (size_t)e * 1024 * 2048, 1024, 2048, (bf16*)(ws + WS_WGU) + (size_t)e * 2048 * 1024, 2, a.in[I_NORM2], scr, r & 511, lane); }
            else { const int r = it - I5, e = r >> 8;
                if (MOE_FP8) p0_transpose_item8(a.in[I_WD] + (size_t)e * 1024 * 1024, 1024, 1024, ws + WS_WD + (size_t)e * 1024 * 1024, 0, nullptr, scr, r & 255, lane);
                else p0_transpose_item(a.in[I_WD] + (size_t)e * 1024 * 1024, 1024, 1024, (bf16*)(ws + WS_WD) + (size_t)e * 1024 * 1024, 0, nullptr, scr, r & 255, lane); }
        }
    }
    P0REP(2) for (int m0 = gw * 4; m0 < T; m0 += NGW * 4) {
        f32x4 v[4][4];
#pragma unroll
        for (int r = 0; r < 4; ++r) { const f32x4* xr = (const f32x4*)(a.in[I_X] + (size_t)(m0 + r) * DM) + lane;
#pragma unroll
            for (int j = 0; j < 4; ++j) v[r][j] = xr[64 * j]; }
#pragma unroll
        for (int r = 0; r < 4; ++r) { float s = 0.f;
#pragma unroll
            for (int j = 0; j < 4; ++j) s += (v[r][j][0] * v[r][j][0] + v[r][j][1] * v[r][j][1]) + (v[r][j][2] * v[r][j][2] + v[r][j][3] * v[r][j][3]);
            const float tot = wave_sum(s); if (lane == 0) ((float*)(ws + WS_RSTD1))[m0 + r] = rsqrtf(tot * (1.0f / DM) + NORM_EPS);
            u32x2* o8 = (u32x2*)((bf16*)(ws + WS_XB) + (size_t)(m0 + r) * DM) + lane;
#pragma unroll
            for (int j = 0; j < 4; ++j) { u32x2 w; w.x = pk2(v[r][j][0], v[r][j][1]); w.y = pk2(v[r][j][2], v[r][j][3]); o8[64 * j] = w; } }
    }
    P0REP(3) for (int idx = gt; idx < SEQ * 32; idx += NT) { const int pos = idx >> 5, i = idx & 31; const double ang = (double)pos * exp(-(double)i * (9.210340371976184 / 32.0));
        ((f32x2*)(ws + WS_ROPE))[idx] = (f32x2){(float)cos(ang), (float)sin(ang)}; }
    P0REP(3) for (int idx = gt; idx < NG * 2 * NP * 65; idx += NT) { const int e = idx % 65, gp = idx / 65, p = gp & 63, dir = (gp >> 6) & 1, g = gp >> 7; double lr, li, dt; s5_mode(a, g, dir, p, lr, li, dt);
        const double mag = exp(lr * dt * e), ang = li * dt * e; ((f32x2*)(ws + WS_POW))[idx] = (f32x2){(float)(mag * cos(ang)), (float)(mag * sin(ang))}; }
    P0REP(3) for (int idx = gt; idx < NG * 2 * NP; idx += NT) { const int p = idx & 63, dir = (idx >> 6) & 1, g = idx >> 7; double lr, li, dt; s5_mode(a, g, dir, p, lr, li, dt);
        const double mag = exp(lr * dt), ar = mag * cos(li * dt), ai = mag * sin(li * dt), nr = ar - 1.0, den = lr * lr + li * li; const float fr = (float)((nr * lr + ai * li) / den), fi = (float)((ai * lr - nr * li) / den);
        for (int cp = 0; cp < 16; ++cp) { const int src = ((dir * NG + g) * NP + p) * GC + cp; const float br = a.in[I_BRE][src], bi = a.in[I_BIM][src]; ((f32x2*)(ws + WS_BF))[idx * 16 + cp] = (f32x2){fr * br - fi * bi, fr * bi + fi * br}; } }
}
__device__ __forceinline__ void p1_expand(const Args& a, int gt, int NT) {
    unsigned char* ws = a.ws; const float* KT = (const float*)(ws + WS_KT); const f32x2* POW = (const f32x2*)(ws + WS_POW); const f32x2* BF = (const f32x2*)(ws + WS_BF);
    bf16* BT2 = (bf16*)(ws + WS_BT2); bf16* BT1 = (bf16*)(ws + WS_BT1);
    for (int idx = gt; idx < NG * 1024 * 160; idx += NT) {
        const int k8 = idx % 160, n = (idx / 160) & 1023, g = idx / 163840, tl = n >> 4, c = n & 15; u32x4 o;
        if (k8 < 128) { const int kp = k8 >> 1, c0 = 8 * (k8 & 1); const float* s = KT + ((size_t)(g * 127 + (tl - kp + 63)) * 16 + c) * 16 + c0; o = pack8(*(const f32x4*)s, *(const f32x4*)(s + 4)); }
        else { const int kk = (k8 - 128) * 8, seg = kk >> 6, p0 = kk & 63, dir = seg >> 1, e = dir == 0 ? tl + 1 : 64 - tl; float v[8];
#pragma unroll
            for (int j = 0; j < 8; ++j) { const int p = p0 + j, src = ((dir * NG + g) * GC + c) * NP + p; const float cr = a.in[I_CRE][src], ci = a.in[I_CIM][src]; const f32x2 pw = POW[(size_t)((g * 2 + dir) * 64 + p) * 65 + e];
                v[j] = (seg & 1) ? -(cr * pw.y + ci * pw.x) : (cr * pw.x - ci * pw.y); }
            o.x = pk2(v[0], v[1]); o.y = pk2(v[2], v[3]); o.z = pk2(v[4], v[5]); o.w = pk2(v[6], v[7]); }
        *(u32x4*)(BT2 + ((size_t)(g * 1024 + n) * KA2 + 8 * k8)) = o;
    }
    for (int idx = gt; idx < NG * 256 * 128; idx += NT) {
        const int k8 = idx & 127, n = (idx >> 7) & 255, g = idx >> 15, kl = k8 >> 1, c0 = 8 * (k8 & 1), seg = n >> 6, p = n & 63, dir = seg >> 1, e = dir == 0 ? 63 - kl : kl;
        const f32x2 pw = POW[(size_t)((g * 2 + dir) * 64 + p) * 65 + e]; float v[8];
#pragma unroll
        for (int j = 0; j < 8; ++j) { const f32x2 b = BF[(size_t)((g * 2 + dir) * 64 + p) * 16 + c0 + j]; v[j] = (seg & 1) ? (pw.x * b.y + pw.y * b.x) : (pw.x * b.x - pw.y * b.y); }
        u32x4 o; o.x = pk2(v[0], v[1]); o.y = pk2(v[2], v[3]); o.z = pk2(v[4], v[5]); o.w = pk2(v[6], v[7]);
        *(u32x4*)(BT1 + ((size_t)(g * 256 + n) * 1024 + 8 * k8)) = o;
    }
}
typedef short v4i16_t __attribute__((ext_vector_type(4)));
__device__ __forceinline__ void attn_unit(LAS unsigned char* lds, const bf16* Q, const bf16* Kb, const bf16* V, bf16* O, float* LSE, int hd, int qb, int tid) {
    const int lane = tid & 63, w = __builtin_amdgcn_readfirstlane(tid >> 6), q = lane & 31, h = lane >> 5;
    const int g = hd >> 2, sh = 2 * g, Ls = SEQ >> sh, prow0 = qb * 256, seq0 = prow0 & ~(Ls - 1);
    const bf16* Kg = Kb + (size_t)hd * T * 64; const bf16* Vg = V + (size_t)hd * T * 64; const bf16* Qg = Q + (size_t)hd * T * 64;
    constexpr int KP = 144;
    LAS unsigned char* Kl = lds; LAS unsigned char* Vl = lds + 384 * KP;
    for (int idx = tid; idx < 3072; idx += NTHREADS) { const int kr = idx >> 3, ch = idx & 7, prow = prow0 - 64 + kr; u32x4 kv = {0u, 0u, 0u, 0u}, vv = {0u, 0u, 0u, 0u};
        if (prow >= seq0 && prow < seq0 + Ls) { kv = *(const u32x4*)(Kg + (size_t)prow * 64 + ch * 8); vv = *(const u32x4*)(Vg + (size_t)prow * 64 + ch * 8); }
        *(LAS u32x4*)(Kl + kr * KP + ch * 16) = kv; *(LAS u32x4*)(Vl + kr * KP + ch * 16) = vv; }
    bf16x8 qf[4];
#pragma unroll
    for (int s = 0; s < 4; ++s) qf[s] = *(const bf16x8*)(Qg + (size_t)(prow0 + 32 * w + q) * 64 + 16 * s + 8 * h);
    __syncthreads();
    f32x16 sc[5];
#pragma unroll
    for (int kb = 0; kb < 5; ++kb) { f32x16 acc = {};
#pragma unroll
        for (int s = 0; s < 4; ++s) { const bf16x8 kf = *(const LAS bf16x8*)(Kl + (32 * w + 32 * kb + q) * KP + (16 * s + 8 * h) * 2); acc = __builtin_amdgcn_mfma_f32_32x32x16_bf16(kf, qf[s], acc, 0, 0, 0); }
        sc[kb] = acc; }
    const int qpos = prow0 + 32 * w + q - seq0; float m = -INFINITY;
#pragma unroll
    for (int kb = 0; kb < 5; ++kb)
#pragma unroll
        for (int r = 0; r < 16; ++r) { const int kpos = prow0 - 64 + 32 * w + 32 * kb + (r & 3) + 8 * (r >> 2) + 4 * h - seq0, d = qpos - kpos;
            const bool ok = (d <= 64) && (d >= -64) && (kpos >= 0) && (kpos < Ls); const float v = ok ? sc[kb][r] : -INFINITY; sc[kb][r] = v; m = fmaxf(m, v); }
    m = fmaxf(m, __shfl_xor(m, 32)); float l = 0.f;
#pragma unroll
    for (int kb = 0; kb < 5; ++kb)
#pragma unroll
        for (int r = 0; r < 16; ++r) { const float pv = exp2f(sc[kb][r] - m); sc[kb][r] = pv; l += pv; }
    l += __shfl_xor(l, 32);
    f32x16 o[2] = {f32x16{}, f32x16{}};
    const int qq = (lane & 15) >> 2, pp = lane & 3, blk = (lane >> 4) & 1;
#pragma unroll
    for (int kb = 0; kb < 5; ++kb)
#pragma unroll
        for (int s2 = 0; s2 < 2; ++s2) {
            u32x4 pw; pw.x = pk2(sc[kb][8 * s2 + 0], sc[kb][8 * s2 + 1]); pw.y = pk2(sc[kb][8 * s2 + 2], sc[kb][8 * s2 + 3]); pw.z = pk2(sc[kb][8 * s2 + 4], sc[kb][8 * s2 + 5]); pw.w = pk2(sc[kb][8 * s2 + 6], sc[kb][8 * s2 + 7]);
            const bf16x8 pf = __builtin_bit_cast(bf16x8, pw);
#pragma unroll
            for (int c = 0; c < 2; ++c) {
                const int row = 32 * w + 32 * kb + 16 * s2 + 4 * h + qq; LAS unsigned char* ad = Vl + row * KP + (32 * c + 16 * blk + 4 * pp) * 2;
                const v4i16_t v0 = __builtin_amdgcn_ds_read_tr16_b64_v4i16((LAS v4i16_t*)ad), v1 = __builtin_amdgcn_ds_read_tr16_b64_v4i16((LAS v4i16_t*)(ad + 8 * KP));
                const bf16x8 vf = {v0[0], v0[1], v0[2], v0[3], v1[0], v1[1], v1[2], v1[3]};
                o[c] = __builtin_amdgcn_mfma_f32_32x32x16_bf16(vf, pf, o[c], 0, 0, 0);
            } }
    const float inv = 1.0f / l, L2 = m + log2f(l);
    const int prow = prow0 + 32 * w + q, b = prow >> 14, pq = prow & 16383, rr = pq >> (14 - sh), ii = pq & (Ls - 1), token = (b << 14) + (ii << sh) + rr;
    bf16* orow = O + ((size_t)g * T + token) * 256 + (hd & 3) * 64;
#pragma unroll
    for (int c = 0; c < 2; ++c)
#pragma unroll
        for (int rb = 0; rb < 4; ++rb) { u32x2 wv; wv.x = pk2(o[c][4 * rb] * inv, o[c][4 * rb + 1] * inv); wv.y = pk2(o[c][4 * rb + 2] * inv, o[c][4 * rb + 3] * inv); *(u32x2*)(orow + 32 * c + 8 * rb + 4 * h) = wv; }
    if (h == 0) LSE[((size_t)g * T + token) * 4 + (hd & 3)] = L2;
    __syncthreads();
}
__device__ __forceinline__ void p3_scan_combine(const Args& a, int gt, int NT) {
    unsigned char* ws = a.ws;
    if (gt < 2 * NG * 128) {
        const int cn = gt & 127, g = (gt >> 7) & 31, b = gt >> 12, dir = cn >> 6, p = cn & 63;
        const f32x2 aL = ((const f32x2*)(ws + WS_POW))[(size_t)((g * 2 + dir) * 64 + p) * 65 + 64];
        const float* E = (const float*)(ws + WS_E) + (size_t)(g * NCH + b * CHB) * 256 + dir * 128 + p; bf16* U = (bf16*)(ws + WS_UA) + (size_t)(g * NCH + b * CHB) * KA2 + 1024 + dir * 128 + p;
        float sr = 0.f, si = 0.f;
        for (int jb = 0; jb < CHB; jb += 8) { float er[8], ei[8];
#pragma unroll
            for (int u = 0; u < 8; ++u) { const int j = dir == 0 ? jb + u : CHB - 1 - (jb + u); er[u] = E[(size_t)j * 256]; ei[u] = E[(size_t)j * 256 + 64]; }
#pragma unroll
            for (int u = 0; u < 8; ++u) { const int j = dir == 0 ? jb + u : CHB - 1 - (jb + u); U[(size_t)j * KA2] = (bf16)f2bf(sr); U[(size_t)j * KA2 + 64] = (bf16)f2bf(si);
                const float nr = aL.x * sr - aL.y * si + er[u], ni = aL.x * si + aL.y * sr + ei[u]; sr = nr; si = ni; } }
    }
    const bf16* O = (const bf16*)(ws + WS_O); const float* LSE = (const float*)(ws + WS_LSE); bf16* AO = (bf16*)(ws + WS_AO);
    for (int idx = gt; idx < T * 32; idx += NT) { const int token = idx >> 5, j = (idx >> 3) & 3, ch = idx & 7;
        const float l0 = LSE[(size_t)token * 4 + j], l1 = LSE[((size_t)T + token) * 4 + j], l2 = LSE[((size_t)2 * T + token) * 4 + j], mx = fmaxf(l0, fmaxf(l1, l2));
        float w0 = exp2f(l0 - mx), w1 = exp2f(l1 - mx), w2 = exp2f(l2 - mx); const float ws_ = 1.0f / (w0 + w1 + w2); w0 *= ws_; w1 *= ws_; w2 *= ws_;
        const size_t off = (size_t)token * 256 + j * 64 + ch * 8; f32x4 a0, b0, a1, b1, a2, b2;
        unpack8(*(const u32x4*)(O + off), a0, b0); unpack8(*(const u32x4*)(O + (size_t)T * 256 + off), a1, b1); unpack8(*(const u32x4*)(O + (size_t)2 * T * 256 + off), a2, b2);
        *(u32x4*)(AO + off) = pack8(a0 * w0 + a1 * w1 + a2 * w2, b0 * w0 + b1 * w1 + b2 * w2); }
}
__device__ __forceinline__ void p8_router(const Args& a, LAS unsigned char* lds, int tid, int blk) {
    unsigned char* ws = a.ws; const int lane = tid & 63, w = __builtin_amdgcn_readfirstlane(tid >> 6), i = lane & 31, h = lane >> 5;
    LAS float* lg = (LAS float*)lds;
    LAS float* ssq = (LAS float*)(lds + 8 * 32 * 33 * 4);
    LAS int* hist = (LAS int*)(lds + 8 * 32 * 33 * 4 + 8 * 64 * 4);
    if (tid < 32) hist[tid] = 0;
    const int task = w & 3, kq = 2 * (w >> 2) + h, tok = blk * 128 + 32 * task + i;
    const float* xr = a.out + (size_t)tok * DM + 256 * kq; const float* g2 = a.in[I_NORM2] + 256 * kq; const float* wr = a.in[I_WR] + (size_t)(256 * kq) * NE + i;
    f32x16 acc = {}; float ss = 0.f;
#pragma unroll 2
    for (int kk = 0; kk < 256; kk += 4) { const f32x4 xv = *(const f32x4*)(xr + kk), gv = *(const f32x4*)(g2 + kk);
#pragma unroll
        for (int u = 0; u < 4; ++u) { acc = __builtin_amdgcn_mfma_f32_32x32x2f32(xv[u] * gv[u], wr[(size_t)(kk + u) * NE], acc, 0, 0, 0); ss += xv[u] * xv[u]; } }
#pragma unroll
    for (int r = 0; r < 16; ++r) lg[(w * 32 + (r & 3) + 8 * (r >> 2) + 4 * h) * 33 + i] = acc[r];
    ssq[w * 64 + lane] = ss;
    __syncthreads();
    if (w < 4 && lane < 32) {
        const float st = (ssq[w * 64 + i] + ssq[w * 64 + 32 + i]) + (ssq[(w + 4) * 64 + i] + ssq[(w + 4) * 64 + 32 + i]); const float rstd = rsqrtf(st * (1.0f / DM) + NORM_EPS);
        float v[32];
#pragma unroll
        for (int e = 0; e < 32; ++e) v[e] = (lg[(w * 32 + i) * 33 + e] + lg[((w + 4) * 32 + i) * 33 + e]) * rstd + a.in[I_BR][e];
        float tv[4]; int ti[4];
#pragma unroll
        for (int k = 0; k < 4; ++k) { float best = -INFINITY; int bi = 0;
#pragma unroll
            for (int e = 0; e < 32; ++e) if (v[e] > best) { best = v[e]; bi = e; }
#pragma unroll
            for (int e = 0; e < 32; ++e) if (e == bi) v[e] = -INFINITY;
            tv[k] = best; ti[k] = bi; }
        const float e1 = __expf(tv[1] - tv[0]), e2 = __expf(tv[2] - tv[0]), e3 = __expf(tv[3] - tv[0]), inv = 1.0f / (1.0f + e1 + e2 + e3);
        const int t2 = blk * 128 + 32 * w + i;
        ((float*)(ws + RT_RSTD2))[t2] = rstd;
        *(f32x4*)((float*)(ws + RT_TOPW) + (size_t)t2 * 4) = (f32x4){inv, e1 * inv, e2 * inv, e3 * inv};
        int* tip = (int*)(ws + RT_TOPI) + (size_t)t2 * 4; tip[0] = ti[0]; tip[1] = ti[1]; tip[2] = ti[2]; tip[3] = ti[3];
#pragma unroll
        for (int k = 0; k < 4; ++k) __hip_atomic_fetch_add(&hist[ti[k]], 1, __ATOMIC_RELAXED, __HIP_MEMORY_SCOPE_WORKGROUP);
    }
    __syncthreads();
    if (tid < 32) ((int*)(ws + RT_CNT))[blk * 32 + tid] = hist[tid];
}
__device__ __forceinline__ void p9_rowlists(const Args& a, LAS unsigned char* lds, int tid, int blk) {
    unsigned char* ws = a.ws; const int lane = tid & 63, w = __builtin_amdgcn_readfirstlane(tid >> 6);
    LAS int* part_all = (LAS int*)lds;
    LAS int* part_pre = part_all + 512;
    LAS int* tot = part_pre + 512;
    LAS int* pre = tot + 32;
    LAS int* base = pre + 32;
    LAS int* wcnt = base + 64;
    const int* CNT = (const int*)(ws + RT_CNT);
    { const int e = tid & 31, part = tid >> 5; int sa = 0, sp = 0;
      for (int bb = 16 * part; bb < 16 * part + 16; ++bb) { const int v = CNT[bb * 32 + e]; sa += v; if (bb < blk) sp += v; }
      part_all[part * 32 + e] = sa; part_pre[part * 32 + e] = sp; }
    __syncthreads();
    if (tid < 32) { int sa = 0, sp = 0; for (int part = 0; part < 16; ++part) { sa += part_all[part * 32 + tid]; sp += part_pre[part * 32 + tid]; } tot[tid] = sa; pre[tid] = sp; }
    __syncthreads();
    if (tid == 0) { int acc = 0; for (int e = 0; e < 32; ++e) { base[e] = acc; acc += (tot[e] + 255) & ~255; } base[32] = acc; }
    const int tok = blk * 128 + (tid >> 2), k = tid & 3; const int e = ((const int*)(ws + RT_TOPI))[(size_t)tok * 4 + k]; const float wv = ((const float*)(ws + RT_TOPW))[(size_t)tok * 4 + k];
    int rank = 0;
#pragma unroll 4
    for (int ee = 0; ee < 32; ++ee) { const unsigned long long mk = __ballot(e == ee); if (e == ee) rank = __popcll(mk & ((1ull << lane) - 1ull)); if (lane == 0) wcnt[w * 32 + ee] = __popcll(mk); }
    __syncthreads();
    int off = 0; for (int ww = 0; ww < w; ++ww) off += wcnt[ww * 32 + e];
    const int dest = base[e] + pre[e] + off + rank;
    ((int*)(ws + RT_ROWTOK))[dest] = tok; ((int*)(ws + RT_ROWDST))[dest] = tok * 4 + k; ((float*)(ws + RT_ROWW))[dest] = wv;
    if (blk == 0) {
        for (int ee = 0; ee < 32; ++ee) { const int s0 = base[ee] + tot[ee], s1 = base[ee + 1]; for (int r = s0 + tid; r < s1; r += NTHREADS) { ((int*)(ws + RT_ROWTOK))[r] = 0; ((int*)(ws + RT_ROWDST))[r] = T * TOPK; ((float*)(ws + RT_ROWW))[r] = 0.f; } }
        if (tid <= 32) ((int*)(ws + RT_META))[tid] = base[tid] >> 8;
    }
    __syncthreads();
}
__device__ __forceinline__ void p12_final(const Args& a, int gt, int NT) {
    const bf16* Y4 = (const bf16*)(a.ws + WS_Y4);
    for (int idx = gt; idx < T * 128; idx += NT) { const int token = idx >> 7, c8 = (idx & 127) * 8; float* o = a.out + (size_t)token * DM + c8; f32x4 va = *(const f32x4*)o, vb = *(const f32x4*)(o + 4);
#pragma unroll
        for (int k = 0; k < 4; ++k) { f32x4 ya, yb; unpack8(*(const u32x4*)(Y4 + ((size_t)token * 4 + k) * DM + c8), ya, yb); va += ya; vb += yb; }
        *(f32x4*)o = va; *(f32x4*)(o + 4) = vb; }
}

#define XB_TMO      128
#define XB_XCNT(j)  (256  + 64 * (j))
#define XB_XSUB(j)  (1280 + 64 * (j))
#define XB_XGEN(j)  (2304 + 64 * (j))
#define XB_TOP      3328
#define XB_TOPGEN   3392
#define XCD_BAR_WORDS 3456
#define XB_SPIN_CAP (1u << 18)
__device__ __forceinline__ unsigned xb_ld(unsigned* p)              { return __hip_atomic_load(p, __ATOMIC_RELAXED, __HIP_MEMORY_SCOPE_AGENT); }
__device__ __forceinline__ unsigned xb_add(unsigned* p, unsigned v) { return __hip_atomic_fetch_add(p, v, __ATOMIC_RELAXED, __HIP_MEMORY_SCOPE_AGENT); }
__device__ __forceinline__ unsigned xb_xcc_id() { return (unsigned)__builtin_amdgcn_s_getreg((3 << 11) | 20) & 0xFu; }
#define XB_SPIN(cond, bar) do { unsigned _sp = 0; while (cond) { __builtin_amdgcn_s_sleep(1); \
    if ((++_sp & 255u) == 0u) { if (xb_ld(&(bar)[XB_TMO])) break; if (_sp > XB_SPIN_CAP) { atomicAdd(&(bar)[XB_TMO], 1u); break; } } } } while (0)
struct XcdBarrier { unsigned* bar; unsigned x; volatile LAS unsigned* st; };
__device__ __forceinline__ XcdBarrier xcd_barrier_post(unsigned* bar, volatile LAS unsigned* st) {
    XcdBarrier b; b.bar = bar; b.x = xb_xcc_id(); b.st = st;
    if (threadIdx.x == 0) (void)xb_add(&bar[XB_XCNT(b.x)], 1u);
    return b;
}
__device__ __forceinline__ void xcd_barrier_complete(unsigned* bar, unsigned x, unsigned& nloc, unsigned& nx) {
    const unsigned G = gridDim.x * gridDim.y * gridDim.z;
    unsigned sum, cnt, mine, sp = 0u;
    for (;;) {
        sum = 0u; cnt = 0u; mine = 0u;
#pragma unroll
        for (unsigned j = 0; j < 16; ++j) { const unsigned c = xb_ld(&bar[XB_XCNT(j)]); sum += c; cnt += (c > 0u) ? 1u : 0u; mine = (j == x) ? c : mine; }
        if (sum == G) break;
        __builtin_amdgcn_s_sleep(1);
        if ((++sp & 255u) == 0u) { if (xb_ld(&bar[XB_TMO])) break; if (sp > XB_SPIN_CAP) { atomicAdd(&bar[XB_TMO], 1u); break; } }
    }
    nloc = mine > 0u ? mine : 1u; nx = cnt > 0u ? cnt : 1u;
}
__device__ __forceinline__ void xcd_barrier(const XcdBarrier& b) {
    asm volatile("s_waitcnt vmcnt(0)" ::: "memory");
    __syncthreads();
    if (threadIdx.x == 0) {
        unsigned* bar = b.bar;
        __builtin_amdgcn_s_waitcnt(0);
        unsigned nloc = b.st[0], nx = b.st[1];
        if (nloc == 0u) { xcd_barrier_complete(bar, b.x, nloc, nx); b.st[0] = nloc; b.st[1] = nx; }
        const unsigned old = xb_add(&bar[XB_XSUB(b.x)], 1u);
        const unsigned gen = old / nloc;
        if (old + 1u == (gen + 1u) * nloc) {
            __builtin_amdgcn_fence(__ATOMIC_RELEASE, "agent");
            asm volatile("s_waitcnt vmcnt(0)" ::: "memory");
            const unsigned og = xb_add(&bar[XB_TOP], 1u);
            const unsigned tg = og / nx;
            if (og + 1u == (tg + 1u) * nx) xb_add(&bar[XB_TOPGEN], 1u);
            else XB_SPIN(xb_ld(&bar[XB_TOPGEN]) == tg, bar);
            __builtin_amdgcn_fence(__ATOMIC_ACQUIRE, "agent");
            xb_add(&bar[XB_XGEN(b.x)], 1u);
            asm volatile("s_waitcnt vmcnt(0)" ::: "memory");
        } else {
            XB_SPIN(xb_ld(&bar[XB_XGEN(b.x)]) == gen, bar);
            __builtin_amdgcn_fence(__ATOMIC_ACQUIRE, "agent");
            asm volatile("s_waitcnt vmcnt(0)" ::: "memory");
        }
    }
    __syncthreads();
}

constexpr int N_PHASES = 13;
__global__ void __launch_bounds__(NTHREADS, 2) mega_fwd(Args args) {
    extern __shared__ __attribute__((aligned(16))) unsigned char lds_[];
    LAS unsigned char* lds = (LAS unsigned char*)lds_;
    volatile LAS unsigned* MISC = (volatile LAS unsigned*)(lds + MISC_OFF);
    const int tid = threadIdx.x, lane = tid & 63, wave = __builtin_amdgcn_readfirstlane(tid >> 6);
    const int G = gridDim.x, bx = blockIdx.x, vcu = (G % 8 == 0) ? (bx % 8) * (G / 8) + bx / 8 : bx;
    unsigned char* ws = args.ws; unsigned* ctl = (unsigned*)(ws + WS_CTL);
    for (int u = tid; u < (LDS_BYTES - LDSX_OFF) / 4; u += NTHREADS) ((LAS unsigned*)(lds + LDSX_OFF))[u] = 0u;
    __syncthreads();
    XcdBarrier bar; bar.bar = ctl + CW_BAR; bar.x = 0; bar.st = nullptr;
    if (MK_N_LAUNCHES == 1) bar = xcd_barrier_post(ctl + CW_BAR, MISC + 8);
    const int lo = args.ph_lo, hi = args.ph_hi;
#define IN(k) (lo <= (k) && (k) < hi)
#define REP(k) for (int rep_ = 0; rep_ < ((((REPEAT_MASK >> (k)) & 1) && ((0x30D >> (k)) & 1)) ? 2 : 1); ++rep_)
#define DUPG(k, stmt) do { stmt; if ((REPEAT_MASK >> (k)) & 1) { stmt; } } while (0)
#define SEAM(k) do { if (IN(k) && IN((k) + 1)) { xcd_barrier(bar); for (int br_ = 0; br_ < BAR_REP; ++br_) xcd_barrier(bar); } } while (0)
    const int gt = vcu * NTHREADS + tid, NT = G * NTHREADS;
    const LAS int* tpre = (const LAS int*)(lds + TPRE_OFF);

    if (IN(0)) REP(0) { p0_prologue(args, lds, tid, lane, wave, vcu, G); }
    SEAM(0);
    if (IN(1)) REP(1) {
        p1_expand(args, gt, NT);
        PolG1 p; p.K = 1024; p.G = G; p.c = bx; p.wsbase = ws; p.rstd1 = (const float*)(ws + WS_RSTD1);
        p.qn = args.in[I_QN]; p.kn = args.in[I_KN]; p.rope = (const float*)(ws + WS_ROPE);
        p.Q = (bf16*)(ws + WS_Q); p.Kb = (bf16*)(ws + WS_K); p.V = (bf16*)(ws + WS_V); p.UA = (bf16*)(ws + WS_UA); p.GT = (bf16*)(ws + WS_GATES);
        pg8::gemm_phase(lds, p);
    }
    SEAM(1);
    if (IN(2)) {
        { PolS5a p; p.K = 1024; p.G = G; p.c = bx; p.wsbase = ws; p.E = (float*)(ws + WS_E); pg8::gemm_phase(lds, p); }
        __syncthreads();
        for (int rp2_ = 0; rp2_ < (((REPEAT_MASK >> 2) & 1) ? 2 : 1); ++rp2_) for (int L = vcu; L < NH * 128; L += G) attn_unit(lds, (const bf16*)(ws + WS_Q), (const bf16*)(ws + WS_K), (const bf16*)(ws + WS_V), (bf16*)(ws + WS_O), (float*)(ws + WS_LSE), L >> 7, L & 127, tid);
    }
    SEAM(2);
    if (IN(3)) REP(3) { p3_scan_combine(args, gt, NT); }
    SEAM(3);
    if (IN(4)) REP(4) { PolS5b p; p.K = KA2; p.G = G; p.vcu = vcu; p.wsbase = ws; p.Z = (bf16*)(ws + WS_Z); pg8::gemm_phase(lds, p); }
    SEAM(4);
    if (IN(5)) REP(5) {
        { PolDense<0> p; p.K = 512; p.G = G; p.c = bx; p.nN = 2; p.wsbase = ws; p.A = DenseA{(unsigned)WS_Z, 512}; p.Bt = (unsigned)WS_WGLU;
          p.in0 = (const bf16*)(ws + WS_Z); p.in1 = nullptr; p.fin = nullptr; p.bias = args.in[I_BGLU]; p.o16 = (bf16*)(ws + WS_GLU); p.o32 = nullptr; DUPG(5, pg8::gemm_phase(lds, p)); }
        { PolDense<1> p; p.K = 256; p.G = G; p.c = bx; p.nN = 4; p.wsbase = ws; p.A = DenseA{(unsigned)WS_AO, 256}; p.Bt = (unsigned)WS_WA;
          p.in0 = (const bf16*)(ws + WS_GATES); p.in1 = nullptr; p.fin = nullptr; p.bias = nullptr; p.o16 = (bf16*)(ws + WS_T1); p.o32 = nullptr; DUPG(5, pg8::gemm_phase(lds, p)); }
    }
    SEAM(5);
    if (IN(6)) REP(6) { PolDense<2> p; p.K = 512; p.G = G; p.c = bx; p.nN = 4; p.wsbase = ws; p.A = DenseA{(unsigned)WS_GLU, 512}; p.Bt = (unsigned)WS_WS;
        p.in0 = (const bf16*)(ws + WS_GATES); p.in1 = (const bf16*)(ws + WS_T1); p.fin = nullptr; p.bias = nullptr; p.o16 = (bf16*)(ws + WS_MIXED); p.o32 = nullptr; DUPG(6, pg8::gemm_phase(lds, p)); }
    SEAM(6);
    if (IN(7)) REP(7) { PolDense<3> p; p.K = 1024; p.G = G; p.c = bx; p.nN = 4; p.wsbase = ws; p.A = DenseA{(unsigned)WS_MIXED, 1024}; p.Bt = (unsigned)WS_WO;
        p.in0 = nullptr; p.in1 = nullptr; p.fin = args.in[I_X]; p.bias = nullptr; p.o16 = (bf16*)(ws + WS_X1B); p.o32 = args.out; DUPG(7, pg8::gemm_phase(lds, p)); }
    SEAM(7);
    if (IN(8)) REP(8) { p8_router(args, lds, tid, bx); }
    SEAM(8);
    if (IN(9)) REP(9) { p9_rowlists(args, lds, tid, bx); }
    SEAM(9);
    if (IN(10)) REP(10) {
        if (tid <= 32) ((LAS int*)(lds + TPRE_OFF))[tid] = ((const int*)(ws + RT_META))[tid];
        __syncthreads();
        PolMoeGU p; p.K = 1024; p.G = G; p.vcu = vcu; p.wsbase = ws; p.tp = tpre; p.rowtok = (const int*)(ws + RT_ROWTOK);
        p.rstd2 = (const float*)(ws + RT_RSTD2); p.bgu = args.in[I_BGU]; p.ACT = ws + WS_ACT; DUPG(10, pg8::gemm_phase(lds, p));
    }
    SEAM(10);
    if (IN(11)) REP(11) {
        if (tid <= 32) ((LAS int*)(lds + TPRE_OFF))[tid] = ((const int*)(ws + RT_META))[tid];
        __syncthreads();
        PolMoeDN p; p.K = 1024; p.G = G; p.vcu = vcu; p.wsbase = ws; p.tp = tpre; p.rowdst = (const int*)(ws + RT_ROWDST);
        p.roww = (const float*)(ws + RT_ROWW); p.bd = args.in[I_BD]; p.Y4 = (bf16*)(ws + WS_Y4); DUPG(11, pg8::gemm_phase(lds, p));
    }
    SEAM(11);
    if (IN(12)) { p12_final(args, gt, NT); }
#undef IN
#undef SEAM
}

extern "C" void kernel_launch(void* const* d_in, const int* in_sizes, int n_in, void* d_out, int out_size, void* d_ws, size_t ws_size, hipStream_t stream) {
    static int grid = 0;
    if (grid == 0) {
        if (n_in != 25 || in_sizes[0] != T * DM || out_size != T * DM || ws_size < WS_END) {
            fprintf(stderr, "kernel_launch: unexpected shapes/workspace: n_in %d in0 %d out %d ws %zu (need %zu); nothing launched\n", n_in, n_in > 0 ? in_sizes[0] : -1, out_size, ws_size, (size_t)WS_END); grid = -1; return; }
        int dev = 0, cus = 0;
        if (hipGetDevice(&dev) != hipSuccess || hipDeviceGetAttribute(&cus, hipDeviceAttributeMultiprocessorCount, dev) != hipSuccess) { fprintf(stderr, "kernel_launch: device query failed\n"); grid = -1; return; }
        if (hipFuncSetAttribute((const void*)mega_fwd, hipFuncAttributeMaxDynamicSharedMemorySize, LDS_BYTES) != hipSuccess) { fprintf(stderr, "kernel_launch: hipFuncSetAttribute failed\n"); grid = -1; return; }
        int per_cu = 0;
        if (hipOccupancyMaxActiveBlocksPerMultiprocessor(&per_cu, (const void*)mega_fwd, NTHREADS, LDS_BYTES) != hipSuccess || per_cu < 1) fprintf(stderr, "kernel_launch: note: occupancy query reports %d blocks per CU\n", per_cu);
        (void)hipGetLastError();
        grid = cus;
        if (grid != 256) fprintf(stderr, "kernel_launch: built for a 256-CU device, got %d CUs\n", grid);
    }
    if (grid < 0) return;
    if (hipMemsetAsync((char*)d_ws + WS_CTL, 0, CTL_ZERO_BYTES, stream) != hipSuccess) { fprintf(stderr, "kernel_launch: memset failed\n"); return; }
    Args a{};
    for (int i = 0; i < 25; ++i) a.in[i] = (const float*)d_in[i];
    a.out = (float*)d_out; a.ws = (unsigned char*)d_ws;
    if (MK_N_LAUNCHES == 1) {
        a.ph_lo = 0; a.ph_hi = N_PHASES;
        hipLaunchKernelGGL(mega_fwd, dim3(grid), dim3(NTHREADS), LDS_BYTES, stream, a);
    } else {
        for (int ph = 0; ph < N_PHASES; ++ph) { a.ph_lo = ph; a.ph_hi = ph + 1; hipLaunchKernelGGL(mega_fwd, dim3(grid), dim3(NTHREADS), LDS_BYTES, stream, a); }
    }
    const hipError_t le = hipPeekAtLastError();
    if (le != hipSuccess) fprintf(stderr, "kernel_launch: launch failed: %s\n", hipGetErrorName(le));
}
```
